# Optimizing an MI355X kernel written in HIP

```python
import jax, jax.numpy as jnp
from jax import lax
import numpy as np

D_MODEL = 1024
BATCH = 4
SEQ = 4096
DEPTH = 1

GRID_W = 64
CTX_LEN = 256
RWKV_HEADS = 8
RWKV_HEAD_DIM = 64
RWKV_WIDTH = RWKV_HEADS * RWKV_HEAD_DIM
DECAY_LORA = 64
ICLR_LORA = 64
GATE_LORA = 128
SGU_WIDTH = 512
SGU_GROUPS = 8
CHUNK = 128
N_EXPERTS = 32
TOP_K = 4
D_EXPERT = D_MODEL
SWIGLU_LIMIT = 7.0
SWIGLU_ALPHA = 1.702
ROW_BLOCK = 128
N_BRANCHES = 2
RMS_EPS = 1e-6
LN_EPS = 1e-5
GN_EPS = 64e-5
RWKV_SPLIT = (RWKV_WIDTH, RWKV_WIDTH, RWKV_WIDTH, DECAY_LORA, DECAY_LORA, ICLR_LORA, ICLR_LORA, GATE_LORA)
RWKV_COLS = 3 * RWKV_WIDTH + 2 * DECAY_LORA + 2 * ICLR_LORA + GATE_LORA
SGU_COLS = 2 * SGU_WIDTH
GATE_COLS = N_BRANCHES * D_MODEL
IN_COLS = RWKV_COLS + SGU_COLS + GATE_COLS

kernel_name = 'hybrid_rwkv7_chunksgu_moe_dit_layer'


def _offsets(sizes):
    out, acc = [], 0
    for s in sizes[:-1]:
        acc += s
        out.append(acc)
    return out


def rmsnorm(x, g):
    xf = x.astype(jnp.float32)
    y = xf * lax.rsqrt(jnp.mean(xf * xf, axis=-1, keepdims=True) + RMS_EPS)
    return (y * g.astype(jnp.float32)).astype(x.dtype)


def layernorm(x, w, b, eps):
    xf = x.astype(jnp.float32)
    mu = jnp.mean(xf, axis=-1, keepdims=True)
    var = jnp.mean(jnp.square(xf - mu), axis=-1, keepdims=True)
    y = (xf - mu) * lax.rsqrt(var + eps)
    return (y * w.astype(jnp.float32) + b.astype(jnp.float32)).astype(x.dtype)


def modulate(h, shift, scale):
    return h * (1.0 + scale) + shift


def q_shift(p):
    B, T, C = p.shape
    rows = T // GRID_W
    g = p.reshape(B, rows, GRID_W, C // 4, 4)
    left = jnp.pad(g[:, :, :-1, :, 0], ((0, 0), (0, 0), (1, 0), (0, 0)))
    right = jnp.pad(g[:, :, 1:, :, 1], ((0, 0), (0, 0), (0, 1), (0, 0)))
    up = jnp.pad(g[:, :-1, :, :, 2], ((0, 0), (1, 0), (0, 0), (0, 0)))
    down = jnp.pad(g[:, 1:, :, :, 3], ((0, 0), (0, 1), (0, 0), (0, 0)))
    return jnp.stack([left, right, up, down], axis=-1).reshape(B, T, C)


def seq_shift(p):
    B, T, C = p.shape
    g = p.reshape(B, T, C // 2, 2)
    prev = jnp.pad(g[:, :-1, :, 0], ((0, 0), (1, 0), (0, 0)))
    nxt = jnp.pad(g[:, 1:, :, 1], ((0, 0), (0, 1), (0, 0)))
    return jnp.stack([prev, nxt], axis=-1).reshape(B, T, C)


def rwkv_inputs(P, shift_fn, lp):
    P = P.astype(jnp.float32)
    P = P + lp['shift_mu'] * (shift_fn(P) - P)
    r, k, v, wd_f, wd_b, ad_f, ad_b, gd = jnp.split(P, _offsets(RWKV_SPLIT), axis=-1)
    B, T, _ = P.shape
    heads = lambda t: t.reshape(B, T, RWKV_HEADS, RWKV_HEAD_DIM)
    kk = heads(k * lp['k_k'])
    kk = kk * lax.rsqrt(jnp.sum(kk * kk, axis=-1, keepdims=True) + 1e-12)
    g = jax.nn.sigmoid(gd) @ lp['gate_lora_b']
    dirs = []
    for d, (wd, ad) in enumerate(((wd_f, ad_f), (wd_b, ad_b))):
        w_log = -jax.nn.softplus(-(lp['decay_w0'][d] + jnp.tanh(wd) @ lp['decay_lora_b'][d])) - 0.5
        decay = jnp.exp(-jnp.exp(w_log))
        a = jax.nn.sigmoid(lp['iclr_a0'][d] + ad @ lp['iclr_lora_b'][d])
        k_d = k * (1.0 + (a - 1.0) * lp['k_a'])
        dirs.append({'w': heads(decay), 'k': heads(k_d), 'a': -kk, 'b': kk * heads(a)})
    return heads(r), heads(v), g, dirs


def wkv_scan(S0, r, w, k, v, a, b, reverse, emit):
    tm = lambda t: jnp.moveaxis(t, 1, 0)

    def step(S, inp):
        r_t, w_t, k_t, v_t, a_t, b_t = inp
        sa = jnp.einsum('bhvk,bhk->bhv', S, a_t)
        S = S * w_t[:, :, None, :] + sa[..., None] * b_t[:, :, None, :] + v_t[..., None] * k_t[:, :, None, :]
        return S, (jnp.einsum('bhvk,bhk->bhv', S, r_t) if emit else None)

    S, y = lax.scan(step, S0, (tm(r), tm(w), tm(k), tm(v), tm(a), tm(b)), reverse=reverse)
    return S, (jnp.moveaxis(y, 0, 1) if emit else None)


def rwkv_readout(y, inputs, lp):
    r, v, g, dirs = inputs
    B, T = y.shape[:2]
    mu = jnp.mean(y, axis=-1, keepdims=True)
    var = jnp.mean(jnp.square(y - mu), axis=-1, keepdims=True)
    yn = ((y - mu) * lax.rsqrt(var + GN_EPS)).reshape(B, T, RWKV_WIDTH) * lp['gn_w'] + lp['gn_b']
    bonus = sum(jnp.sum(r * dd['k'] * lp['r_k'], axis=-1, keepdims=True) for dd in dirs) * v
    return ((yn + bonus.reshape(B, T, RWKV_WIDTH)) * g) @ lp['w_out_rwkv']


def rwkv_branch(P_ctx, P_lat, lp, ctx_out):
    ctx_in = rwkv_inputs(P_ctx, seq_shift, lp)
    lat_in = rwkv_inputs(P_lat, q_shift, lp)
    B = P_lat.shape[0]
    S0 = jnp.zeros((B, RWKV_HEADS, RWKV_HEAD_DIM, RWKV_HEAD_DIM), jnp.float32)
    y_lat, y_ctx = 0.0, 0.0
    for d, rev in enumerate((False, True)):
        rc, vc, _, dc = ctx_in
        S_c, yc = wkv_scan(S0, rc, dc[d]['w'], dc[d]['k'], vc, dc[d]['a'], dc[d]['b'], rev, ctx_out)
        rl, vl, _, dl = lat_in
        _, yl = wkv_scan(S_c, rl, dl[d]['w'], dl[d]['k'], vl, dl[d]['a'], dl[d]['b'], rev, True)
        y_lat = y_lat + yl
        if ctx_out:
            y_ctx = y_ctx + yc
    out_lat = rwkv_readout(y_lat, lat_in, lp).astype(P_lat.dtype)
    out_ctx = rwkv_readout(y_ctx, ctx_in, lp).astype(P_ctx.dtype) if ctx_out else None
    return out_lat, out_ctx


def chunk_sgu(P_sgu, lp):
    u, z = jnp.split(jax.nn.gelu(P_sgu, approximate=False), 2, axis=-1)
    z = layernorm(z, lp['sgu_ln_w'], lp['sgu_ln_b'], LN_EPS)
    B, T, C = z.shape
    zc = z.reshape(B, T // CHUNK, CHUNK, SGU_GROUPS, C // SGU_GROUPS)
    s = jnp.einsum('gpq,bnqgc->bnpgc', lp['sgu_w_spatial'], zc) + lp['sgu_b_spatial'].T[:, :, None]
    return u * s.reshape(B, T, C)


def merge_out(P_rest, y_a, lp):
    P_sgu, P_gate = jnp.split(P_rest, [SGU_COLS], axis=-1)
    y_b = chunk_sgu(P_sgu, lp) @ lp['w_out_sgu']
    gate_a, gate_b = jnp.split(jax.nn.sigmoid(P_gate), N_BRANCHES, axis=-1)
    return (gate_a * y_a + gate_b * y_b) @ lp['w_o']


def clamped_swiglu(gate, up):
    gate = jnp.minimum(gate, SWIGLU_LIMIT)
    up = jnp.clip(up, -SWIGLU_LIMIT, SWIGLU_LIMIT)
    return gate * jax.nn.sigmoid(SWIGLU_ALPHA * gate) * (up + 1.0)


def moe_ffn(h, lp):
    B, T, D = h.shape
    xf = h.reshape(-1, D)
    n_tok = xf.shape[0]
    logits = (xf @ lp['router_w'] + lp['router_b']).astype(jnp.float32)
    top_v, top_e = lax.top_k(logits, TOP_K)
    weights = jax.nn.softmax(top_v, axis=-1)
    n_assign = n_tok * TOP_K
    flat_e = top_e.reshape(-1)
    order = jnp.argsort(flat_e)
    sorted_e = flat_e[order]
    sorted_tok = (order // TOP_K).astype(jnp.int32)
    sorted_w = weights.reshape(-1)[order]
    counts = jnp.bincount(flat_e, length=N_EXPERTS)
    padded = (counts + ROW_BLOCK - 1) // ROW_BLOCK * ROW_BLOCK
    pad_end = jnp.cumsum(padded)
    pad_start = pad_end - padded
    grp_start = jnp.cumsum(counts) - counts
    dest = pad_start[sorted_e] + (jnp.arange(n_assign, dtype=jnp.int32) - grp_start[sorted_e])
    n_rows = (n_assign + N_EXPERTS * (ROW_BLOCK - 1) + ROW_BLOCK - 1) // ROW_BLOCK * ROW_BLOCK
    n_blocks = n_rows // ROW_BLOCK
    row_tok = jnp.zeros((n_rows,), jnp.int32).at[dest].set(sorted_tok)
    block_start = jnp.arange(n_blocks, dtype=jnp.int32) * ROW_BLOCK
    block_e = jnp.minimum(jnp.searchsorted(pad_end, block_start, side='right'), N_EXPERTS - 1)
    xb = xf[row_tok].reshape(n_blocks, ROW_BLOCK, D)

    def expert_block(args):
        xblk, e = args
        gate = xblk @ lp['exp_w_gate'][e] + lp['exp_b_gate'][e]
        up = xblk @ lp['exp_w_up'][e] + lp['exp_b_up'][e]
        return clamped_swiglu(gate, up) @ lp['exp_w_down'][e] + lp['exp_b_down'][e]

    yb = lax.map(expert_block, (xb, block_e)).reshape(n_rows, D)
    contrib = yb[dest] * sorted_w[:, None].astype(yb.dtype)
    out = jax.ops.segment_sum(contrib, sorted_tok, num_segments=n_tok)
    return out.reshape(B, T, D).astype(h.dtype)


def setup_inputs(seed: int = 0) -> dict:
    key = jax.random.key(seed)
    ks = iter(jax.random.split(key, 48))
    nrm = lambda shape, scale: jax.random.normal(next(ks), shape, jnp.float32) * scale
    L, D, W, E, F = DEPTH, D_MODEL, RWKV_WIDTH, N_EXPERTS, D_EXPERT
    return {
        'x': nrm((BATCH, SEQ, D), 1.0),
        'c': nrm((BATCH, D), 1.0),
        'ctx': nrm((BATCH, CTX_LEN, D), 1.0),
        'c_ctx': nrm((D,), 1.0),
        'w_ada': nrm((L, D, 6 * D), 0.5 * D ** -0.5),
        'b_ada': nrm((L, 6 * D), 0.02),
        'norm1_g': 1.0 + nrm((L, D), 0.01),
        'w_in': nrm((L, D, IN_COLS), D ** -0.5),
        'shift_mu': jax.random.uniform(next(ks), (L, RWKV_COLS), jnp.float32),
        'decay_w0': -2.0 + nrm((L, 2, W), 1.0),
        'decay_lora_b': nrm((L, 2, DECAY_LORA, W), 0.5 * DECAY_LORA ** -0.5),
        'iclr_a0': nrm((L, 2, W), 0.5),
        'iclr_lora_b': nrm((L, 2, ICLR_LORA, W), 0.5 * ICLR_LORA ** -0.5),
        'gate_lora_b': nrm((L, GATE_LORA, W), GATE_LORA ** -0.5),
        'k_k': 1.0 + nrm((L, W), 0.1),
        'k_a': 1.0 + nrm((L, W), 0.1),
        'r_k': nrm((L, RWKV_HEADS, RWKV_HEAD_DIM), 0.1),
        'gn_w': 1.0 + nrm((L, W), 0.01),
        'gn_b': nrm((L, W), 0.01),
        'w_out_rwkv': nrm((L, W, D), W ** -0.5),
        'sgu_ln_w': 1.0 + nrm((L, SGU_WIDTH), 0.01),
        'sgu_ln_b': nrm((L, SGU_WIDTH), 0.01),
        'sgu_w_spatial': nrm((L, SGU_GROUPS, CHUNK, CHUNK), CHUNK ** -0.5),
        'sgu_b_spatial': 1.0 + nrm((L, SGU_GROUPS, CHUNK), 0.1),
        'w_out_sgu': nrm((L, SGU_WIDTH, D), SGU_WIDTH ** -0.5),
        'w_o': nrm((L, D, D), D ** -0.5),
        'norm2_g': 1.0 + nrm((L, D), 0.01),
        'router_w': nrm((L, D, E), D ** -0.5),
        'router_b': nrm((L, E), 0.01),
        'exp_w_gate': nrm((L, E, D, F), D ** -0.5),
        'exp_b_gate': nrm((L, E, F), 0.01),
        'exp_w_up': nrm((L, E, D, F), D ** -0.5),
        'exp_b_up': nrm((L, E, F), 0.01),
        'exp_w_down': nrm((L, E, F, D), F ** -0.5),
        'exp_b_down': nrm((L, E, D), 0.01),
        'final_norm_g': 1.0 + nrm((D,), 0.01),
    }


def reference(x, c, ctx, c_ctx, w_ada, b_ada, norm1_g, w_in, shift_mu, decay_w0, decay_lora_b,
              iclr_a0, iclr_lora_b, gate_lora_b, k_k, k_a, r_k, gn_w, gn_b, w_out_rwkv,
              sgu_ln_w, sgu_ln_b, sgu_w_spatial, sgu_b_spatial, w_out_sgu, w_o, norm2_g,
              router_w, router_b, exp_w_gate, exp_b_gate, exp_w_up, exp_b_up, exp_w_down,
              exp_b_down, final_norm_g):
    for l in range(DEPTH):
        last = l == DEPTH - 1
        lp = {
            'shift_mu': shift_mu[l], 'decay_w0': decay_w0[l], 'decay_lora_b': decay_lora_b[l],
            'iclr_a0': iclr_a0[l], 'iclr_lora_b': iclr_lora_b[l], 'gate_lora_b': gate_lora_b[l],
            'k_k': k_k[l], 'k_a': k_a[l], 'r_k': r_k[l], 'gn_w': gn_w[l], 'gn_b': gn_b[l],
            'w_out_rwkv': w_out_rwkv[l], 'sgu_ln_w': sgu_ln_w[l], 'sgu_ln_b': sgu_ln_b[l],
            'sgu_w_spatial': sgu_w_spatial[l], 'sgu_b_spatial': sgu_b_spatial[l],
            'w_out_sgu': w_out_sgu[l], 'w_o': w_o[l], 'router_w': router_w[l],
            'router_b': router_b[l], 'exp_w_gate': exp_w_gate[l], 'exp_b_gate': exp_b_gate[l],
            'exp_w_up': exp_w_up[l], 'exp_b_up': exp_b_up[l], 'exp_w_down': exp_w_down[l],
            'exp_b_down': exp_b_down[l],
        }
        mod = jax.nn.silu(c) @ w_ada[l] + b_ada[l]
        mod_c = jax.nn.silu(c_ctx) @ w_ada[l] + b_ada[l]
        sh1, sc1, ga1, sh2, sc2, ga2 = [m[:, None, :] for m in jnp.split(mod, 6, axis=-1)]
        csh1, csc1, cga1, csh2, csc2, cga2 = jnp.split(mod_c, 6, axis=-1)

        h = modulate(rmsnorm(x, norm1_g[l]), sh1, sc1)
        hc = modulate(rmsnorm(ctx, norm1_g[l]), csh1, csc1)
        P = h @ w_in[l]
        Pc = hc @ (w_in[l, :, :RWKV_COLS] if last else w_in[l])
        y_a, y_a_ctx = rwkv_branch(Pc[..., :RWKV_COLS], P[..., :RWKV_COLS], lp, not last)
        x_new = x + ga1 * merge_out(P[..., RWKV_COLS:], y_a, lp)
        if not last:
            ctx = ctx + cga1 * merge_out(Pc[..., RWKV_COLS:], y_a_ctx, lp)
        x = x_new

        h = modulate(rmsnorm(x, norm2_g[l]), sh2, sc2)
        x = x + ga2 * moe_ffn(h, lp)
        if not last:
            hc = modulate(rmsnorm(ctx, norm2_g[l]), csh2, csc2)
            ctx = ctx + cga2 * moe_ffn(hc, lp)
    return rmsnorm(x, final_norm_g)
```

```cpp
#include <hip/hip_runtime.h>
#include <cstdio>
#include <cstdint>

#define XB_TMO      128
#define XB_XCNT(j)  (256  + 64 * (j))
#define XB_XSUB(j)  (1280 + 64 * (j))
#define XB_XGEN(j)  (2304 + 64 * (j))
#define XB_TOP      3328
#define XB_TOPGEN   3392
#define XCD_BAR_WORDS 3456
#define XB_SPIN_CAP (1u << 21)
#define LAS __attribute__((address_space(3)))

__device__ __forceinline__ unsigned xb_ld(unsigned* p)              { return __hip_atomic_load(p, __ATOMIC_RELAXED, __HIP_MEMORY_SCOPE_AGENT); }
__device__ __forceinline__ unsigned xb_add(unsigned* p, unsigned v) { return __hip_atomic_fetch_add(p, v, __ATOMIC_RELAXED, __HIP_MEMORY_SCOPE_AGENT); }
__device__ __forceinline__ unsigned xb_xcc_id() { return (unsigned)__builtin_amdgcn_s_getreg((3 << 11) | 20) & 0xFu; }
#define XB_SPIN(cond, bar) do { unsigned _sp = 0; while (cond) { __builtin_amdgcn_s_sleep(1); \
    if ((++_sp & 255u) == 0u) { if (xb_ld(&(bar)[XB_TMO])) break; if (_sp > XB_SPIN_CAP) { atomicAdd(&(bar)[XB_TMO], 1u); break; } } } } while (0)

struct XcdBarrier {
    unsigned* bar; unsigned x;
    volatile LAS unsigned* st;
};

__device__ __forceinline__ XcdBarrier xcd_barrier_post(unsigned* bar, volatile LAS unsigned* st) {
    XcdBarrier b; b.bar = bar; b.x = xb_xcc_id(); b.st = st;
    if (threadIdx.x == 0) (void)xb_add(&bar[XB_XCNT(b.x)], 1u);
    return b;
}
__device__ __forceinline__ void xcd_barrier_complete(unsigned* bar, unsigned x, unsigned& nloc, unsigned& nx) {
    const unsigned G = gridDim.x * gridDim.y * gridDim.z;
    unsigned sum, cnt, mine, sp = 0u;
    for (;;) {
        sum = 0u; cnt = 0u; mine = 0u;
#pragma unroll
        for (unsigned j = 0; j < 16; ++j) { const unsigned c = xb_ld(&bar[XB_XCNT(j)]); sum += c; cnt += (c > 0u) ? 1u : 0u; mine = (j == x) ? c : mine; }
        if (sum == G) break;
        __builtin_amdgcn_s_sleep(1);
        if ((++sp & 255u) == 0u) { if (xb_ld(&bar[XB_TMO])) break; if (sp > XB_SPIN_CAP) { atomicAdd(&bar[XB_TMO], 1u); break; } }
    }
    nloc = mine > 0u ? mine : 1u; nx = cnt > 0u ? cnt : 1u;
}

__device__ __forceinline__ void xcd_barrier(const XcdBarrier& b) {
    asm volatile("s_waitcnt vmcnt(0)" ::: "memory");
    __syncthreads();
    if (threadIdx.x == 0) {
        unsigned* bar = b.bar;
        __builtin_amdgcn_s_waitcnt(0);
        unsigned nloc = b.st[0], nx = b.st[1];
        if (nloc == 0u) { xcd_barrier_complete(bar, b.x, nloc, nx); b.st[0] = nloc; b.st[1] = nx; }
        const unsigned old = xb_add(&bar[XB_XSUB(b.x)], 1u);
        const unsigned gen = old / nloc;
        if (old + 1u == (gen + 1u) * nloc) {
            __builtin_amdgcn_fence(__ATOMIC_RELEASE, "agent");
            asm volatile("s_waitcnt vmcnt(0)" ::: "memory");
            const unsigned og = xb_add(&bar[XB_TOP], 1u);
            const unsigned tg = og / nx;
            if (og + 1u == (tg + 1u) * nx) xb_add(&bar[XB_TOPGEN], 1u);
            else XB_SPIN(xb_ld(&bar[XB_TOPGEN]) == tg, bar);
            __builtin_amdgcn_fence(__ATOMIC_ACQUIRE, "agent");
            xb_add(&bar[XB_XGEN(b.x)], 1u);
            asm volatile("s_waitcnt vmcnt(0)" ::: "memory");
        } else {
            XB_SPIN(xb_ld(&bar[XB_XGEN(b.x)]) == gen, bar);
            __builtin_amdgcn_fence(__ATOMIC_ACQUIRE, "agent");
            asm volatile("s_waitcnt vmcnt(0)" ::: "memory");
        }
    }
    __syncthreads();
}

constexpr int D = 1024, NB = 4, SEQ = 4096, NTOK = NB * SEQ, CTXL = 256, NCTX = NB * CTXL, NROW = NTOK + NCTX;
constexpr int RW = 512, NH = 8, HD = 64, RCOLS = 1920, INC = 4992, PRW_LD = 2048;
constexpr int NE = 32, TOPK = 4, ECAP = NTOK;
constexpr int NT = 512;
typedef float f4 __attribute__((ext_vector_type(4)));
typedef unsigned short bf16_t;
typedef unsigned u32x2 __attribute__((ext_vector_type(2)));
typedef unsigned u32x4 __attribute__((ext_vector_type(4)));
typedef short bf16x8_t __attribute__((ext_vector_type(8)));

typedef float f32x2_cv __attribute__((ext_vector_type(2)));
typedef __bf16 bf16x2_cv __attribute__((ext_vector_type(2)));
__device__ __forceinline__ unsigned cvt_pk_bf16(float lo, float hi) { return __builtin_bit_cast(unsigned, __builtin_convertvector((f32x2_cv){lo, hi}, bf16x2_cv)); }
__device__ __forceinline__ float bf_lo(unsigned w) { return __uint_as_float(w << 16); }
__device__ __forceinline__ float bf_hi(unsigned w) { return __uint_as_float(w & 0xffff0000u); }
__device__ __forceinline__ float bf2f(bf16_t b) { return __uint_as_float(((unsigned)b) << 16); }
__device__ __forceinline__ bf16_t f2bf(float f) { return (bf16_t)(cvt_pk_bf16(f, 0.f) & 0xffffu); }

constexpr size_t MiB = 1024 * 1024;
constexpr size_t WS_CTL = 0;
constexpr size_t CTL_BYTES = 65536;
constexpr size_t WS_MOD = WS_CTL + CTL_BYTES;
constexpr size_t WS_LIST = WS_MOD + 131072;
constexpr size_t WS_WGT = WS_LIST + (size_t)NE * ECAP * 4;
constexpr size_t WS_WRT = 3 * MiB;
constexpr size_t WS_GS2 = WS_WRT + 131072, WS_BIAS2 = WS_GS2 + 16384;
constexpr size_t WS_WINT = 4 * MiB;
constexpr size_t WS_WOR = 14 * MiB;
constexpr size_t WS_WOS = 15 * MiB;
constexpr size_t WS_WOT = 16 * MiB;
constexpr size_t WS_LORAT = 18 * MiB;
constexpr size_t WS_GA = 20 * MiB;
constexpr size_t WS_M = 52 * MiB;
constexpr size_t WS_H = 84 * MiB;
constexpr size_t WS_PRW = 118 * MiB;
constexpr size_t WS_GSGU = 186 * MiB;
constexpr size_t WS_GB = 218 * MiB;
constexpr size_t WS_AS = 250 * MiB;
constexpr size_t WS_R = 84 * MiB, WS_A = 101 * MiB, WS_V = 186 * MiB, WS_KRAW = 203 * MiB, WS_ALORA = 220 * MiB;
constexpr size_t WS_LW = 118 * MiB, WS_KD = 152 * MiB, WS_B = 235 * MiB, WS_G = 269 * MiB, WS_YD = 203 * MiB, WS_AR = 286 * MiB;
constexpr size_t WS_X1 = 84 * MiB, WS_H2 = 20 * MiB, WS_ACT = 148 * MiB;
constexpr size_t WS_W1T = 320 * MiB;
constexpr size_t WS_W2T = 448 * MiB;
constexpr size_t WS_END = 512 * MiB;
constexpr int CW_CNT = 4096;
constexpr int ACT_ROWS = 65536 + 32 * 256;
static_assert(XCD_BAR_WORDS <= CW_CNT, "ctl layout");
static_assert(WS_WGT + 65536 * 4 <= WS_WRT && WS_BIAS2 + 512 <= WS_WINT, "misc region");
static_assert((size_t)ACT_ROWS * 1024 * 2 <= 144 * MiB, "act region");

struct Args { const float* in[36]; float* out; unsigned char* ws; int ph_lo, ph_hi; };
struct Frame { const float* const* in; float* out; unsigned char* ws; LAS float* sm; LAS unsigned char* lds; int tid, lane, wave, G, bid; };

__device__ __forceinline__ float wave_sum(float v) {
#pragma unroll
    for (int o = 32; o >= 1; o >>= 1) v += __shfl_xor(v, o);
    return v;
}
__device__ __forceinline__ float sigmoid_acc(float x) { return 1.0f / (1.0f + expf(-x)); }
__device__ __forceinline__ float sigmoid_fast(float x) { return __builtin_amdgcn_rcpf(1.0f + __expf(-x)); }

namespace mg {
typedef short bf16x8 __attribute__((ext_vector_type(8)));
typedef float f32x4 __attribute__((ext_vector_type(4)));
typedef float f32x2 __attribute__((ext_vector_type(2)));
constexpr int BM = 256, BK = 64, HALF = 128, HTB = HALF * BK * 2, STAGE_BYTES = 8 * HTB, NXCD = 8, WGM = 8;
__device__ __forceinline__ int lds_byte(int r, int c) { const int st = (r >> 4) * 2 + (c >> 5), rr = r & 15, cc = c & 31, ob = rr * 64 + cc * 2; return st * 1024 + (ob ^ (((ob >> 9) & 1) << 5)); }
__device__ __forceinline__ void stage_rc(int b, int& R, int& C) { const int st = b / 1024, sb = b % 1024, swz = sb ^ (((sb >> 9) & 1) << 5); R = (st >> 1) * 16 + swz / 64; C = (st & 1) * 32 + (swz % 64) / 2; }
__device__ __forceinline__ int perm32(int rho) { const int n = rho >> 4, i = rho & 15; return 8 * (i >> 2) + 4 * n + (i & 3); }
struct Unit { int pm, pn, e; };

__device__ __forceinline__ f32x2 gelu_pk(f32x2 v) {
    const f32x2 av = __builtin_elementwise_abs(v), d = av * 0.2316418882f + 1.0f;
    f32x2 t; t.x = __builtin_amdgcn_rcpf(d.x); t.y = __builtin_amdgcn_rcpf(d.y);
    f32x2 q = t * 0.5307027145f + (-0.7265760135f); q = q * t + 0.7107068705f; q = q * t + (-0.142248368f); q = q * t + 0.127414796f; q = q * t;
    const f32x2 s = (v * v) * (-0.72134752044f);
    f32x2 e; e.x = __builtin_amdgcn_exp2f(s.x); e.y = __builtin_amdgcn_exp2f(s.y);
    const f32x2 m = v * (q * e), r = v - m;
    f32x2 o; o.x = v.x < 0.f ? m.x : r.x; o.y = v.y < 0.f ? m.y : r.y; return o;
}

__device__ __forceinline__ bool static_order(int L, int nM, int nN, Unit& u) {
    const int nwg = nM * nN; if (L >= nwg) return false;
    int wgid = L; { const int q = nwg / NXCD, r = nwg % NXCD, xcd = wgid % NXCD, off = wgid / NXCD; wgid = (xcd < r ? xcd * (q + 1) : r * (q + 1) + (xcd - r) * q) + off; }
    const int nig = WGM * nN, gid = wgid / nig, fm = gid * WGM, gsz = (nM - fm) < WGM ? (nM - fm) : WGM;
    u.pm = fm + ((wgid % nig) % gsz); u.pn = (wgid % nig) / gsz; u.e = 0; return true;
}

template <class Prob, class Epi>
__device__ __forceinline__ void gemm_run(LAS unsigned char* lds, const Prob& P, const Epi& E) {
    const int tid = threadIdx.x, wid = __builtin_amdgcn_readfirstlane(tid >> 6), lane = tid & 63, wr = wid >> 2, wc = wid & 3, fr = lane & 15, fq = lane >> 4;
    const int K = P.K, nt = K / BK;
    int sR[2], sC[2]; unsigned voffB[2];
#pragma unroll
    for (int i = 0; i < 2; ++i) { int R, C; stage_rc(tid * 16 + i * 8192, R, C); sR[i] = R; sC[i] = C; const int Rb = Epi::PERM ? ((R & ~31) + perm32(R & 31)) : R; voffB[i] = (unsigned)(Rb * K + C) * 2u; }
    const size_t kstep = (size_t)(BK * 2);
    const size_t hstep = (size_t)HALF * K * 2;
    const unsigned ldsw = (unsigned)wid * 1024u;
    const int aoff = lds_byte(wr * 64 + fr, fq * 8), boff = lds_byte(wc * 32 + fr, fq * 8);
#define MG_SA(b, h) (((b) * 2 + (h)) * HTB)
#define MG_SB(b, h) ((4 + (b) * 2 + (h)) * HTB)
#define MG_STAGE(bufoff, gbase, voff) do { _Pragma("unroll") for (int _i = 0; _i < 2; ++_i) \
        __builtin_amdgcn_global_load_lds((const unsigned*)((const char*)(gbase) + (voff)[_i]), (LAS unsigned*)(lds + (bufoff) + ldsw + _i * 8192), 16, 0, 0); } while (0)
#define MG_LDA(dst, b, h) do { _Pragma("unroll") for (int m = 0; m < 4; ++m) _Pragma("unroll") for (int k = 0; k < 2; ++k) dst[m][k] = *(const LAS bf16x8*)(lds + MG_SA(b, h) + aoff + m * 2048 + k * 1024); } while (0)
#define MG_LDB(dst, b, h) do { _Pragma("unroll") for (int n = 0; n < 2; ++n) _Pragma("unroll") for (int k = 0; k < 2; ++k) dst[n][k] = *(const LAS bf16x8*)(lds + MG_SB(b, h) + boff + n * 2048 + k * 1024); } while (0)
#define MG_MMA(ai, bj, At, Bt) do { __builtin_amdgcn_s_setprio(1); _Pragma("unroll") for (int m = 0; m < 4; ++m) _Pragma("unroll") for (int n = 0; n < 2; ++n) _Pragma("unroll") for (int k = 0; k < 2; ++k) \
        acc[ai][bj][m][n] = __builtin_amdgcn_mfma_f32_16x16x32_bf16(Bt[n][k], At[m][k], acc[ai][bj][m][n], 0, 0, 0); __builtin_amdgcn_s_setprio(0); } while (0)
#define MG_WAIT_V(n) asm volatile("s_waitcnt vmcnt(" #n ")" ::: "memory")
#define MG_WAIT_L(n) asm volatile("s_waitcnt lgkmcnt(" #n ")" ::: "memory")
#define MG_BAR __builtin_amdgcn_s_barrier()
#define MG_SCHED __builtin_amdgcn_sched_barrier(0)
    Unit cur, nxt; int ui = 0;
    if (!P.next(0, cur)) return;
    f32x4 acc[2][2][4][2];
#pragma unroll
    for (int a = 0; a < 2; ++a)
#pragma unroll
        for (int b = 0; b < 2; ++b)
#pragma unroll
            for (int m = 0; m < 4; ++m)
#pragma unroll
                for (int n = 0; n < 2; ++n) acc[a][b][m][n] = (f32x4){0.f, 0.f, 0.f, 0.f};
    bf16x8 At[4][2], B0[2][2], B1[2][2];
    unsigned aoC[2][2], aoN[2][2];
    P.a_offs(cur, sR, sC, aoC);
    const char* const Ab = P.a_base();
    const char* cB = P.b_base(cur);
    MG_STAGE(MG_SB(0, 0), cB, voffB); MG_STAGE(MG_SA(0, 0), Ab, aoC[0]); MG_STAGE(MG_SB(0, 1), cB + hstep, voffB); MG_STAGE(MG_SA(0, 1), Ab, aoC[1]);
    if (wr == 1) MG_BAR;
    MG_WAIT_V(4); MG_BAR;
    MG_STAGE(MG_SB(1, 0), cB + kstep, voffB); MG_STAGE(MG_SA(1, 0), Ab + kstep, aoC[0]); MG_STAGE(MG_SB(1, 1), cB + hstep + kstep, voffB);
    MG_WAIT_V(6); MG_BAR;
    for (;;) {
        const bool has_next = P.next(ui + 1, nxt);
        const char* nB = cB;
        if (has_next) { P.a_offs(nxt, sR, sC, aoN); nB = P.b_base(nxt); }
        else { aoN[0][0] = aoC[0][0]; aoN[0][1] = aoC[0][1]; aoN[1][0] = aoC[1][0]; aoN[1][1] = aoC[1][1]; }
        for (int t = 0; t < nt; t += 2) {
            const bool last = (t == nt - 2);
            const char* a1 = Ab + (size_t)(t + 1) * kstep;
            const char* a2 = last ? Ab : Ab + (size_t)(t + 2) * kstep; const char* b2 = last ? nB : cB + (size_t)(t + 2) * kstep;
            const char* a3 = a2 + kstep; const char* b3 = b2 + kstep;
            unsigned o0[2], o1[2];
            o0[0] = last ? aoN[0][0] : aoC[0][0]; o0[1] = last ? aoN[0][1] : aoC[0][1]; o1[0] = last ? aoN[1][0] : aoC[1][0]; o1[1] = last ? aoN[1][1] : aoC[1][1];
            MG_LDB(B0, 0, 0); MG_SCHED; MG_LDA(At, 0, 0); MG_STAGE(MG_SA(1, 1), a1, aoC[1]);
            MG_WAIT_L(8); MG_BAR; MG_WAIT_L(0); MG_MMA(0, 0, At, B0); MG_BAR; MG_SCHED;
            MG_LDB(B1, 0, 1); MG_STAGE(MG_SB(0, 0), b2, voffB);
            MG_BAR; MG_WAIT_L(0); MG_MMA(0, 1, At, B1); MG_BAR;
            MG_LDA(At, 0, 1); MG_STAGE(MG_SA(0, 0), a2, o0);
            MG_BAR; MG_WAIT_L(0); MG_MMA(1, 0, At, B0); MG_BAR; MG_SCHED;
            MG_STAGE(MG_SB(0, 1), b2 + hstep, voffB);
            MG_WAIT_V(6); MG_BAR; MG_MMA(1, 1, At, B1); MG_BAR;
            MG_LDB(B0, 1, 0); MG_SCHED; MG_LDA(At, 1, 0); MG_STAGE(MG_SA(0, 1), a2, o1);
            MG_WAIT_L(8); MG_BAR; MG_WAIT_L(0); MG_MMA(0, 0, At, B0); MG_BAR; MG_SCHED;
            MG_LDB(B1, 1, 1); MG_STAGE(MG_SB(1, 0), b3, voffB);
            MG_BAR; MG_WAIT_L(0); MG_MMA(0, 1, At, B1); MG_BAR;
            MG_LDA(At, 1, 1); MG_STAGE(MG_SA(1, 0), a3, o0);
            MG_BAR; MG_WAIT_L(0); MG_MMA(1, 0, At, B0); MG_BAR; MG_SCHED;
            MG_STAGE(MG_SB(1, 1), b3 + hstep, voffB);
            MG_WAIT_V(6); MG_BAR; MG_MMA(1, 1, At, B1); MG_BAR;
        }
        MG_SCHED; asm volatile("s_nop 15\n\ts_nop 7" ::: "memory"); MG_SCHED;
        E(acc, cur, wr, wc, fr, fq);
        if (!has_next) break;
#pragma unroll
        for (int a = 0; a < 2; ++a)
#pragma unroll
            for (int b = 0; b < 2; ++b)
#pragma unroll
                for (int m = 0; m < 4; ++m)
#pragma unroll
                    for (int n = 0; n < 2; ++n) acc[a][b][m][n] = (f32x4){0.f, 0.f, 0.f, 0.f};
        cur = nxt; cB = nB; ++ui;
        aoC[0][0] = aoN[0][0]; aoC[0][1] = aoN[0][1]; aoC[1][0] = aoN[1][0]; aoC[1][1] = aoN[1][1];
    }
    MG_WAIT_V(0);
    if (wr == 0) MG_BAR;
    MG_BAR;
#undef MG_SA
#undef MG_SB
#undef MG_STAGE
#undef MG_LDA
#undef MG_LDB
#undef MG_MMA
#undef MG_WAIT_V
#undef MG_WAIT_L
#undef MG_BAR
#undef MG_SCHED
}

struct DenseProb {
    const bf16_t* A; const bf16_t* Bt; int nM, nN, K, G, c;
    __device__ __forceinline__ bool next(int i, Unit& u) const { return static_order(i * G + c, nM, nN, u); }
    __device__ __forceinline__ const char* a_base() const { return (const char*)A; }
    __device__ __forceinline__ const char* b_base(const Unit& u) const { return (const char*)Bt + (size_t)u.pn * BM * K * 2; }
    __device__ __forceinline__ void a_offs(const Unit& u, const int (&sR)[2], const int (&sC)[2], unsigned (&o)[2][2]) const {
#pragma unroll
        for (int h = 0; h < 2; ++h)
#pragma unroll
            for (int i = 0; i < 2; ++i) o[h][i] = (unsigned)((u.pm * BM + h * HALF + sR[i]) * K + sC[i]) * 2u; }
};
struct PProb {
    const bf16_t* A; const bf16_t* Bt; int G, c; static constexpr int K = 1024;
    __device__ __forceinline__ bool next(int i, Unit& u) const { const int L = i * G + c; if (L < 1280) return static_order(L, 64, 20, u);
        if (L >= 1312) return false; const int t = L - 1280; u.pm = 64 + (t >> 3); u.pn = t & 7; u.e = 0; return true; }
    __device__ __forceinline__ const char* a_base() const { return (const char*)A; }
    __device__ __forceinline__ const char* b_base(const Unit& u) const { return (const char*)Bt + (size_t)u.pn * BM * K * 2; }
    __device__ __forceinline__ void a_offs(const Unit& u, const int (&sR)[2], const int (&sC)[2], unsigned (&o)[2][2]) const {
#pragma unroll
        for (int h = 0; h < 2; ++h)
#pragma unroll
            for (int i = 0; i < 2; ++i) o[h][i] = (unsigned)((u.pm * BM + h * HALF + sR[i]) * K + sC[i]) * 2u; }
};
__device__ __forceinline__ int moe_expert_of(LAS const int* tb, int rt) { int e = 0;
#pragma unroll
    for (int i = 1; i < NE; ++i) e = (tb[32 + i] <= rt) ? i : e;
    return e; }
struct Moe1Prob {
    const bf16_t* H2; const bf16_t* W1t; const int* lst; LAS const int* tb; int G, c; static constexpr int K = 1024;
    __device__ __forceinline__ bool next(int i, Unit& u) const { const int RT = tb[65]; int rt, ct;
        if (G == 256) { const int xcd = c & 7, r = c >> 3, s = i * 8 + xcd; rt = 4 * s + (r & 3); ct = r >> 2; } else { const int L = i * G + c; rt = L >> 3; ct = L & 7; }
        if (rt >= RT) return false; u.pm = rt; u.pn = ct; u.e = moe_expert_of(tb, rt); return true; }
    __device__ __forceinline__ const char* a_base() const { return (const char*)H2; }
    __device__ __forceinline__ const char* b_base(const Unit& u) const { return (const char*)W1t + ((size_t)u.e * 2048 + (size_t)u.pn * 256) * K * 2; }
    __device__ __forceinline__ void a_offs(const Unit& u, const int (&sR)[2], const int (&sC)[2], unsigned (&o)[2][2]) const {
        const int g0 = (u.pm - tb[32 + u.e]) * 256, cnt = tb[u.e];
#pragma unroll
        for (int h = 0; h < 2; ++h)
#pragma unroll
            for (int i = 0; i < 2; ++i) { const int gi = g0 + h * HALF + sR[i]; const int as = gi < cnt ? lst[(size_t)u.e * ECAP + gi] : 0; o[h][i] = (unsigned)((as >> 2) * K + sC[i]) * 2u; } }
};
struct Moe2Prob {
    const bf16_t* Act; const bf16_t* W2t; LAS const int* tb; int G, c; static constexpr int K = 1024;
    __device__ __forceinline__ bool next(int i, Unit& u) const { const int RT = tb[65]; int rt, ct;
        if (G == 256) { const int xcd = c & 7, r = c >> 3, s = i * 8 + xcd; rt = 8 * s + (r & 7); ct = r >> 3; } else { const int L = i * G + c; rt = L >> 2; ct = L & 3; }
        if (rt >= RT) return false; u.pm = rt; u.pn = ct; u.e = moe_expert_of(tb, rt); return true; }
    __device__ __forceinline__ const char* a_base() const { return (const char*)Act; }
    __device__ __forceinline__ const char* b_base(const Unit& u) const { return (const char*)W2t + ((size_t)u.e * 1024 + (size_t)u.pn * 256) * K * 2; }
    __device__ __forceinline__ void a_offs(const Unit& u, const int (&sR)[2], const int (&sC)[2], unsigned (&o)[2][2]) const {
#pragma unroll
        for (int h = 0; h < 2; ++h)
#pragma unroll
            for (int i = 0; i < 2; ++i) o[h][i] = (unsigned)((u.pm * BM + h * HALF + sR[i]) * K + sC[i]) * 2u; }
};

struct EpiP {
    static constexpr bool PERM = true;
    bf16_t* Prw; bf16_t* Gsgu; bf16_t* GateA; bf16_t* GateB;
    __device__ __forceinline__ void operator()(const f32x4 (&acc)[2][2][4][2], const Unit& u, int wr, int wc, int fr, int fq) const {
        const int row0 = u.pm * BM + wr * 64 + fr, colt = wc * 32 + 8 * fq;
        bf16_t* base; int ld, mode;
        if (u.pn < 8) { base = Prw + u.pn * 256; ld = PRW_LD; mode = 0; }
        else if (u.pn < 12) { base = Gsgu + (u.pn - 8) * 256; ld = 1024; mode = 1; }
        else if (u.pn < 16) { base = GateA + (u.pn - 12) * 256; ld = 1024; mode = 2; }
        else { base = GateB + (u.pn - 16) * 256; ld = 1024; mode = 2; }
#pragma unroll
        for (int ai = 0; ai < 2; ++ai)
#pragma unroll
            for (int m = 0; m < 4; ++m) { bf16_t* rowp = base + (size_t)(row0 + ai * HALF + m * 16) * ld + colt;
#pragma unroll
                for (int bj = 0; bj < 2; ++bj) { f32x4 v0 = acc[ai][bj][m][0], v1 = acc[ai][bj][m][1];
                    if (mode == 1) { const f32x2 a = gelu_pk((f32x2){v0[0], v0[1]}), b = gelu_pk((f32x2){v0[2], v0[3]}), c = gelu_pk((f32x2){v1[0], v1[1]}), d = gelu_pk((f32x2){v1[2], v1[3]});
                        v0 = (f32x4){a.x, a.y, b.x, b.y}; v1 = (f32x4){c.x, c.y, d.x, d.y}; }
                    if (mode == 2) {
#pragma unroll
                        for (int j = 0; j < 4; ++j) { v0[j] = sigmoid_fast(v0[j]); v1[j] = sigmoid_fast(v1[j]); } }
                    u32x4 w; w.x = cvt_pk_bf16(v0[0], v0[1]); w.y = cvt_pk_bf16(v0[2], v0[3]); w.z = cvt_pk_bf16(v1[0], v1[1]); w.w = cvt_pk_bf16(v1[2], v1[3]);
                    *(u32x4*)(rowp + bj * HALF) = w; } }
    }
};
template <bool ACCUM> struct EpiGateMul {
    static constexpr bool PERM = true;
    bf16_t* Mo; const bf16_t* gate;
    __device__ __forceinline__ void operator()(const f32x4 (&acc)[2][2][4][2], const Unit& u, int wr, int wc, int fr, int fq) const {
        const int row0 = u.pm * BM + wr * 64 + fr, col0 = u.pn * BM + wc * 32 + 8 * fq;
#pragma unroll
        for (int ai = 0; ai < 2; ++ai)
#pragma unroll
            for (int m = 0; m < 4; ++m) { const size_t ro = (size_t)(row0 + ai * HALF + m * 16) * 1024 + col0;
#pragma unroll
                for (int bj = 0; bj < 2; ++bj) { const f32x4 v0 = acc[ai][bj][m][0], v1 = acc[ai][bj][m][1];
                    const u32x4 g = *(const u32x4*)(gate + ro + bj * HALF);
                    float o[8] = {bf_lo(g.x) * v0[0], bf_hi(g.x) * v0[1], bf_lo(g.y) * v0[2], bf_hi(g.y) * v0[3], bf_lo(g.z) * v1[0], bf_hi(g.z) * v1[1], bf_lo(g.w) * v1[2], bf_hi(g.w) * v1[3]};
                    if (ACCUM) { const u32x4 p = *(const u32x4*)(Mo + ro + bj * HALF);
                        o[0] += bf_lo(p.x); o[1] += bf_hi(p.x); o[2] += bf_lo(p.y); o[3] += bf_hi(p.y); o[4] += bf_lo(p.z); o[5] += bf_hi(p.z); o[6] += bf_lo(p.w); o[7] += bf_hi(p.w); }
                    u32x4 w; w.x = cvt_pk_bf16(o[0], o[1]); w.y = cvt_pk_bf16(o[2], o[3]); w.z = cvt_pk_bf16(o[4], o[5]); w.w = cvt_pk_bf16(o[6], o[7]);
                    *(u32x4*)(Mo + ro + bj * HALF) = w; } }
    }
};
struct EpiX1 {
    static constexpr bool PERM = false;
    float* x1; const float* x; const float* mod;
    __device__ __forceinline__ void operator()(const f32x4 (&acc)[2][2][4][2], const Unit& u, int wr, int wc, int fr, int fq) const {
        const int row0 = u.pm * BM + wr * 64 + fr, col0 = u.pn * BM + wc * 32 + 4 * fq;
        const float* gp = mod + (size_t)((u.pm * BM) / SEQ) * 6144 + 2048 + col0;
        f32x4 gv[2][2];
#pragma unroll
        for (int bj = 0; bj < 2; ++bj)
#pragma unroll
            for (int n = 0; n < 2; ++n) gv[bj][n] = *(const f32x4*)(gp + bj * HALF + n * 16);
#pragma unroll
        for (int ai = 0; ai < 2; ++ai)
#pragma unroll
            for (int m = 0; m < 4; ++m) { const size_t ro = (size_t)(row0 + ai * HALF + m * 16) * D + col0;
#pragma unroll
                for (int bj = 0; bj < 2; ++bj)
#pragma unroll
                    for (int n = 0; n < 2; ++n) { const f32x4 xv = *(const f32x4*)(x + ro + bj * HALF + n * 16); *(f32x4*)(x1 + ro + bj * HALF + n * 16) = xv + gv[bj][n] * acc[ai][bj][m][n]; } }
    }
};
struct EpiMoe1 {
    static constexpr bool PERM = true;
    bf16_t* act; const float* bg; const float* bu;
    __device__ __forceinline__ void operator()(const f32x4 (&acc)[2][2][4][2], const Unit& u, int wr, int wc, int fr, int fq) const {
        const int row0 = u.pm * BM + wr * 64 + fr, col0 = u.pn * 128 + wc * 32 + 8 * fq;
        f32x4 bgv[2], buv[2];
#pragma unroll
        for (int n = 0; n < 2; ++n) { bgv[n] = *(const f32x4*)(bg + u.e * 1024 + col0 + 4 * n); buv[n] = *(const f32x4*)(bu + u.e * 1024 + col0 + 4 * n); }
#pragma unroll
        for (int ai = 0; ai < 2; ++ai)
#pragma unroll
            for (int m = 0; m < 4; ++m) { float o[8];
#pragma unroll
                for (int n = 0; n < 2; ++n) { const f32x4 g4 = acc[ai][0][m][n] + bgv[n], u4 = acc[ai][1][m][n] + buv[n];
#pragma unroll
                    for (int j = 0; j < 4; ++j) { const float g = fminf(g4[j], 7.0f), uu = fminf(fmaxf(u4[j], -7.0f), 7.0f); o[n * 4 + j] = g * sigmoid_fast(1.702f * g) * (uu + 1.0f); } }
                u32x4 w; w.x = cvt_pk_bf16(o[0], o[1]); w.y = cvt_pk_bf16(o[2], o[3]); w.z = cvt_pk_bf16(o[4], o[5]); w.w = cvt_pk_bf16(o[6], o[7]);
                *(u32x4*)(act + (size_t)(row0 + ai * HALF + m * 16) * 1024 + col0) = w; }
    }
};
struct EpiMoe2 {
    static constexpr bool PERM = true;
    bf16_t* ys; const float* bd; const int* lst; const float* wgt; LAS const int* tb;
    __device__ __forceinline__ void operator()(const f32x4 (&acc)[2][2][4][2], const Unit& u, int wr, int wc, int fr, int fq) const {
        const int g0 = (u.pm - tb[32 + u.e]) * 256 + wr * 64 + fr, cnt = tb[u.e], col0 = u.pn * BM + wc * 32 + 8 * fq;
        f32x4 bv[2][2];
#pragma unroll
        for (int bj = 0; bj < 2; ++bj)
#pragma unroll
            for (int n = 0; n < 2; ++n) bv[bj][n] = *(const f32x4*)(bd + u.e * 1024 + col0 + bj * HALF + 4 * n);
#pragma unroll
        for (int ai = 0; ai < 2; ++ai)
#pragma unroll
            for (int m = 0; m < 4; ++m) { const int gi = g0 + ai * HALF + m * 16;
                if (gi < cnt) { const int as = lst[(size_t)u.e * ECAP + gi]; const float w = wgt[as];
#pragma unroll
                    for (int bj = 0; bj < 2; ++bj) { const f32x4 v0 = (acc[ai][bj][m][0] + bv[bj][0]) * w, v1 = (acc[ai][bj][m][1] + bv[bj][1]) * w;
                        u32x4 o; o.x = cvt_pk_bf16(v0[0], v0[1]); o.y = cvt_pk_bf16(v0[2], v0[3]); o.z = cvt_pk_bf16(v1[0], v1[1]); o.w = cvt_pk_bf16(v1[2], v1[3]);
                        *(u32x4*)(ys + (size_t)as * 1024 + col0 + bj * HALF) = o; } } }
    }
};
struct EpiLora {
    static constexpr bool PERM = true;
    bf16_t* LW; bf16_t* KD; bf16_t* Bd; bf16_t* G; const bf16_t* Kraw; const bf16_t* A; const float* w0; const float* a0; const float* k_a;
    __device__ __forceinline__ void operator()(const f32x4 (&acc)[2][2][4][2], const Unit& u, int wr, int wc, int fr, int fq) const {
        const int row0 = u.pm * BM + wr * 64 + fr, ch0 = (u.pn & 1) * 256 + wc * 32 + 8 * fq, type = u.pn >> 1, d = type & 1;
        const size_t dofs = (size_t)d * NROW * RW;
#pragma unroll
        for (int bj = 0; bj < 2; ++bj) { const int ch = ch0 + bj * HALF;
            if (type < 2) { const f32x4 wv0 = *(const f32x4*)(w0 + d * RW + ch), wv1 = *(const f32x4*)(w0 + d * RW + ch + 4);
#pragma unroll
                for (int ai = 0; ai < 2; ++ai)
#pragma unroll
                    for (int m = 0; m < 4; ++m) { const f32x4 x0 = acc[ai][bj][m][0] + wv0, x1 = acc[ai][bj][m][1] + wv1; float o[8];
#pragma unroll
                        for (int j = 0; j < 4; ++j) { o[j] = -0.6065306597f * sigmoid_fast(x0[j]); o[4 + j] = -0.6065306597f * sigmoid_fast(x1[j]); }
                        u32x4 w; w.x = cvt_pk_bf16(o[0], o[1]); w.y = cvt_pk_bf16(o[2], o[3]); w.z = cvt_pk_bf16(o[4], o[5]); w.w = cvt_pk_bf16(o[6], o[7]);
                        *(u32x4*)(LW + dofs + (size_t)(row0 + ai * HALF + m * 16) * RW + ch) = w; }
            } else if (type < 4) { const f32x4 av0 = *(const f32x4*)(a0 + d * RW + ch), av1 = *(const f32x4*)(a0 + d * RW + ch + 4), ka0 = *(const f32x4*)(k_a + ch), ka1 = *(const f32x4*)(k_a + ch + 4);
#pragma unroll
                for (int ai = 0; ai < 2; ++ai)
#pragma unroll
                    for (int m = 0; m < 4; ++m) { const size_t ro = (size_t)(row0 + ai * HALF + m * 16) * RW + ch;
                        const f32x4 x0 = acc[ai][bj][m][0] + av0, x1 = acc[ai][bj][m][1] + av1; const u32x4 kw = *(const u32x4*)(Kraw + ro), aw = *(const u32x4*)(A + ro);
                        const float kr[8] = {bf_lo(kw.x), bf_hi(kw.x), bf_lo(kw.y), bf_hi(kw.y), bf_lo(kw.z), bf_hi(kw.z), bf_lo(kw.w), bf_hi(kw.w)};
                        const float na[8] = {bf_lo(aw.x), bf_hi(aw.x), bf_lo(aw.y), bf_hi(aw.y), bf_lo(aw.z), bf_hi(aw.z), bf_lo(aw.w), bf_hi(aw.w)};
                        float okd[8], ob[8];
#pragma unroll
                        for (int j = 0; j < 4; ++j) { const float s0 = sigmoid_fast(x0[j]), s1 = sigmoid_fast(x1[j]);
                            okd[j] = kr[j] * (1.0f + (s0 - 1.0f) * ka0[j]); ob[j] = -na[j] * s0; okd[4 + j] = kr[4 + j] * (1.0f + (s1 - 1.0f) * ka1[j]); ob[4 + j] = -na[4 + j] * s1; }
                        u32x4 w1, w2; w1.x = cvt_pk_bf16(okd[0], okd[1]); w1.y = cvt_pk_bf16(okd[2], okd[3]); w1.z = cvt_pk_bf16(okd[4], okd[5]); w1.w = cvt_pk_bf16(okd[6], okd[7]);
                        w2.x = cvt_pk_bf16(ob[0], ob[1]); w2.y = cvt_pk_bf16(ob[2], ob[3]); w2.z = cvt_pk_bf16(ob[4], ob[5]); w2.w = cvt_pk_bf16(ob[6], ob[7]);
                        *(u32x4*)(KD + dofs + ro) = w1; *(u32x4*)(Bd + dofs + ro) = w2; }
            } else {
#pragma unroll
                for (int ai = 0; ai < 2; ++ai)
#pragma unroll
                    for (int m = 0; m < 4; ++m) { const f32x4 x0 = acc[ai][bj][m][0], x1 = acc[ai][bj][m][1];
                        u32x4 w; w.x = cvt_pk_bf16(x0[0], x0[1]); w.y = cvt_pk_bf16(x0[2], x0[3]); w.z = cvt_pk_bf16(x1[0], x1[1]); w.w = cvt_pk_bf16(x1[2], x1[3]);
                        *(u32x4*)(G + (size_t)(row0 + ai * HALF + m * 16) * RW + ch) = w; }
            } }
    }
};
}

constexpr int CV_LDB = 272;
__device__ __forceinline__ void cvt_tile(const Frame& F, const float* src, int ldw, bf16_t* dst, int ldd) {
    LAS unsigned char* ts = F.lds;
    const int nq = F.tid & 31, kg = F.tid >> 5;
    f4 v[8];
#pragma unroll
    for (int j = 0; j < 8; ++j) v[j] = *(const f4*)(src + (size_t)(kg * 8 + j) * ldw + nq * 4);
    __syncthreads();
#pragma unroll
    for (int c = 0; c < 4; ++c) { u32x4 w; w.x = cvt_pk_bf16(v[0][c], v[1][c]); w.y = cvt_pk_bf16(v[2][c], v[3][c]); w.z = cvt_pk_bf16(v[4][c], v[5][c]); w.w = cvt_pk_bf16(v[6][c], v[7][c]);
        *(LAS u32x4*)(ts + (nq * 4 + c) * CV_LDB + kg * 16) = w; }
    __syncthreads();
#pragma unroll
    for (int it = 0; it < 4; ++it) { const int slot = it * NT + F.tid, kq = slot & 15, n = slot >> 4;
        const u32x4 w = *(LAS u32x4*)(ts + n * CV_LDB + kq * 16);
        *(u32x4*)(dst + (size_t)n * ldd + kq * 8) = w; }
}
__device__ __forceinline__ void p_cvt_small(const Frame& F) {
    bf16_t* WinT = (bf16_t*)(F.ws + WS_WINT); bf16_t* WoR = (bf16_t*)(F.ws + WS_WOR); bf16_t* WoS = (bf16_t*)(F.ws + WS_WOS); bf16_t* WoT = (bf16_t*)(F.ws + WS_WOT);
    for (int t = F.bid; t < 312 + 32 + 32 + 64; t += F.G) {
        if (t < 312) { const int kt = t / 39, ntl = t % 39, n0 = ntl * 128, r0 = n0 < 1920 ? n0 : n0 + 128;
            cvt_tile(F, F.in[7] + (size_t)kt * 128 * INC + n0, INC, WinT + (size_t)r0 * 1024 + kt * 128, 1024); }
        else if (t < 376) { const int j = (t - 312) & 31, kt = j >> 3, ntl = j & 7; const bool sg = t >= 344;
            cvt_tile(F, (sg ? F.in[24] : F.in[19]) + (size_t)kt * 128 * 1024 + ntl * 128, 1024, (sg ? WoS : WoR) + (size_t)ntl * 128 * 512 + kt * 128, 512); }
        else { const int j = t - 376, kt = j >> 3, ntl = j & 7;
            cvt_tile(F, F.in[25] + (size_t)kt * 128 * 1024 + ntl * 128, 1024, WoT + (size_t)ntl * 128 * 1024 + kt * 128, 1024); }
    }
}
__device__ __forceinline__ void p_cvt_experts(const Frame& F) {
    bf16_t* W1t = (bf16_t*)(F.ws + WS_W1T); bf16_t* W2t = (bf16_t*)(F.ws + WS_W2T);
    for (int t = F.bid; t < NE * 192; t += F.G) {
        const int e = t / 192, j = t % 192, which = j >> 6, kt = (j & 63) >> 3, ntl = j & 7;
        const float* src = (which == 0 ? F.in[29] : which == 1 ? F.in[31] : F.in[33]) + (size_t)e * D * D + (size_t)kt * 128 * D + ntl * 128;
        bf16_t* dst = which == 2 ? W2t + ((size_t)e * 1024 + ntl * 128) * 1024 + kt * 128
                                 : W1t + ((size_t)e * 2048 + ntl * 256 + (which == 1 ? 128 : 0)) * 1024 + kt * 128;
        cvt_tile(F, src, D, dst, 1024);
    }
}

__device__ __forceinline__ void p_mod(const Frame& F) {
    const float* c = F.in[1]; const float* cc = F.in[3]; const float* w = F.in[4]; const float* b = F.in[5];
    float* mod = (float*)(F.ws + WS_MOD);
    LAS float* sc = F.sm;
    LAS float* red = F.sm + 5 * 1024;
    if (F.bid < 96) {
        for (int i = F.tid; i < 5 * 1024; i += NT) { const int r = i >> 10, k = i & 1023; const float x = r < 4 ? c[r * D + k] : cc[k]; sc[i] = x * sigmoid_acc(x); }
    }
    for (int u = F.bid; u < 96; u += F.G) {
        __syncthreads();
        const int col = u * 64 + F.lane, k0 = F.wave * 128;
        float a0 = 0.f, a1 = 0.f, a2 = 0.f, a3 = 0.f, a4 = 0.f;
#pragma unroll 16
        for (int k = 0; k < 128; ++k) { const float wv = w[(size_t)(k0 + k) * 6144 + col];
            a0 = fmaf(sc[k0 + k], wv, a0); a1 = fmaf(sc[1024 + k0 + k], wv, a1); a2 = fmaf(sc[2048 + k0 + k], wv, a2); a3 = fmaf(sc[3072 + k0 + k], wv, a3); a4 = fmaf(sc[4096 + k0 + k], wv, a4); }
        red[(F.wave * 5 + 0) * 64 + F.lane] = a0; red[(F.wave * 5 + 1) * 64 + F.lane] = a1; red[(F.wave * 5 + 2) * 64 + F.lane] = a2; red[(F.wave * 5 + 3) * 64 + F.lane] = a3; red[(F.wave * 5 + 4) * 64 + F.lane] = a4;
        __syncthreads();
        if (F.tid < 320) { const int r = F.tid >> 6, cl = F.tid & 63; float t = b[u * 64 + cl];
#pragma unroll
            for (int wv = 0; wv < 8; ++wv) t += red[(wv * 5 + r) * 64 + cl];
            mod[r * 6144 + u * 64 + cl] = t; }
    }
}
__device__ __forceinline__ void p_norm1(const Frame& F, bf16_t* dst) {
    const float* mod = (const float*)(F.ws + WS_MOD); const float* g = F.in[6];
    for (int row = F.bid * 8 + F.wave; row < NROW; row += F.G * 8) {
        const float* src; int r;
        if (row < NTOK) { src = F.in[0] + (size_t)row * D; r = row / SEQ; } else { src = F.in[2] + (size_t)(row - NTOK) * D; r = 4; }
        f4 v[4]; float ss = 0.f;
#pragma unroll
        for (int i = 0; i < 4; ++i) { v[i] = *(const f4*)(src + i * 256 + F.lane * 4); ss += v[i].x * v[i].x + v[i].y * v[i].y + v[i].z * v[i].z + v[i].w * v[i].w; }
        ss = wave_sum(ss);
        const float rs = rsqrtf(ss * (1.0f / D) + 1e-6f);
#pragma unroll
        for (int i = 0; i < 4; ++i) {
            const int cidx = i * 256 + F.lane * 4;
            const f4 gg = *(const f4*)(g + cidx), sh = *(const f4*)(mod + r * 6144 + cidx), sc = *(const f4*)(mod + r * 6144 + 1024 + cidx);
            u32x2 o; o.x = cvt_pk_bf16(v[i].x * rs * gg.x * (1.f + sc.x) + sh.x, v[i].y * rs * gg.y * (1.f + sc.y) + sh.y);
            o.y = cvt_pk_bf16(v[i].z * rs * gg.z * (1.f + sc.z) + sh.z, v[i].w * rs * gg.w * (1.f + sc.w) + sh.w);
            *(u32x2*)(dst + (size_t)row * D + cidx) = o;
        }
    }
}
template <int CTRL> __device__ __forceinline__ float dpp_f(float x) { return __int_as_float(__builtin_amdgcn_update_dpp(0, __float_as_int(x), CTRL, 0xF, 0xF, false)); }
__device__ __forceinline__ float sum8(float x) { x += dpp_f<0xB1>(x); x += dpp_f<0x4E>(x); x += dpp_f<0x141>(x); return x; }
__device__ __forceinline__ float sum16(float x) { x = sum8(x); x += dpp_f<0x140>(x); return x; }
__device__ __forceinline__ void p_cvt_lora(const Frame& F) {
    bf16_t* T = (bf16_t*)(F.ws + WS_LORAT);
    for (int idx = F.bid * NT + F.tid; idx < 2560 * 384; idx += F.G * NT) {
        const int n = idx / 384, kc = idx % 384, seg = n >> 9, ch = n & 511; float v = 0.f;
        if (seg < 2) { if ((kc >> 6) == seg) v = F.in[10][((size_t)seg * 64 + (kc & 63)) * RW + ch]; }
        else if (seg < 4) { if ((kc >> 6) == seg) v = F.in[12][((size_t)(seg - 2) * 64 + (kc & 63)) * RW + ch]; }
        else { if (kc >= 256) v = F.in[13][(size_t)(kc - 256) * RW + ch]; }
        T[idx] = f2bf(v);
    }
}
__device__ __forceinline__ void p_prepA(const Frame& F, const bf16_t* P, bf16_t* R, bf16_t* Kraw, bf16_t* V, bf16_t* A, bf16_t* Alora) {
    const float* mu = F.in[8]; const float* k_k = F.in[14];
    for (int row = F.bid * 8 + F.wave; row < NROW; row += F.G * 8) {
        const bf16_t* own = P + (size_t)row * PRW_LD;
        const bf16_t* nb[4]; bool ok[4];
        if (row < NTOK) { const int t = row % SEQ, gy = t >> 6, gx = t & 63;
            nb[0] = own - PRW_LD; ok[0] = gx > 0; nb[1] = own + PRW_LD; ok[1] = gx < 63; nb[2] = own - 64 * PRW_LD; ok[2] = gy > 0; nb[3] = own + 64 * PRW_LD; ok[3] = gy < 63;
        } else { const int t = (row - NTOK) % CTXL;
            nb[0] = own - PRW_LD; ok[0] = t > 0; nb[1] = own + PRW_LD; ok[1] = t < CTXL - 1; nb[2] = nb[0]; ok[2] = ok[0]; nb[3] = nb[1]; ok[3] = ok[1]; }
#pragma unroll
        for (int seg = 0; seg < 4; ++seg) {
            if (seg == 3 && F.lane >= 48) break;
            const int c0 = seg * 512 + F.lane * 8;
            const u32x4 pw = *(const u32x4*)(own + c0);
            u32x4 nw[4];
#pragma unroll
            for (int q = 0; q < 4; ++q) nw[q] = ok[q] ? *(const u32x4*)(nb[q] + c0) : (u32x4){0u, 0u, 0u, 0u};
            const f4 m0 = *(const f4*)(mu + c0), m1 = *(const f4*)(mu + c0 + 4);
            const float p[8] = {bf_lo(pw.x), bf_hi(pw.x), bf_lo(pw.y), bf_hi(pw.y), bf_lo(pw.z), bf_hi(pw.z), bf_lo(pw.w), bf_hi(pw.w)};
            const float sv[8] = {bf_lo(nw[0].x), bf_hi(nw[1].x), bf_lo(nw[2].y), bf_hi(nw[3].y), bf_lo(nw[0].z), bf_hi(nw[1].z), bf_lo(nw[2].w), bf_hi(nw[3].w)};
            const float mv[8] = {m0.x, m0.y, m0.z, m0.w, m1.x, m1.y, m1.z, m1.w};
            float o[8];
#pragma unroll
            for (int j = 0; j < 8; ++j) o[j] = p[j] + mv[j] * (sv[j] - p[j]);
            const size_t ro = (size_t)row * RW + F.lane * 8;
#define PK8(x_) (u32x4){cvt_pk_bf16(x_[0], x_[1]), cvt_pk_bf16(x_[2], x_[3]), cvt_pk_bf16(x_[4], x_[5]), cvt_pk_bf16(x_[6], x_[7])}
            if (seg == 0) { *(u32x4*)(R + ro) = PK8(o); }
            else if (seg == 2) { *(u32x4*)(V + ro) = PK8(o); }
            else if (seg == 1) {
                *(u32x4*)(Kraw + ro) = PK8(o);
                const f4 q0 = *(const f4*)(k_k + F.lane * 8), q1 = *(const f4*)(k_k + F.lane * 8 + 4);
                float x[8] = {o[0] * q0.x, o[1] * q0.y, o[2] * q0.z, o[3] * q0.w, o[4] * q1.x, o[5] * q1.y, o[6] * q1.z, o[7] * q1.w};
                float ss = 0.f;
#pragma unroll
                for (int j = 0; j < 8; ++j) ss += x[j] * x[j];
                const float rn = -rsqrtf(sum8(ss) + 1e-12f);
#pragma unroll
                for (int j = 0; j < 8; ++j) x[j] *= rn;
                *(u32x4*)(A + ro) = PK8(x);
            } else {
                if (F.lane < 16) {
#pragma unroll
                    for (int j = 0; j < 8; ++j) o[j] = tanhf(o[j]); }
                else if (F.lane >= 32) {
#pragma unroll
                    for (int j = 0; j < 8; ++j) o[j] = sigmoid_acc(o[j]); }
                u32x4 w; w.x = cvt_pk_bf16(o[0], o[1]); w.y = cvt_pk_bf16(o[2], o[3]); w.z = cvt_pk_bf16(o[4], o[5]); w.w = cvt_pk_bf16(o[6], o[7]);
                *(u32x4*)(Alora + (size_t)row * 384 + F.lane * 8) = w;
            }
        }
    }
}
constexpr int CQ_PITCH = 144, CQ_BYTES = 64 * CQ_PITCH, CQ_PER_WAVE = 24;
__device__ __forceinline__ void cq_decode(const Frame& F, int g, const float*& src, bf16_t*& dst) {
    const int m = g >> 8, e = m / 3, which = m - e * 3, kt = (g >> 4) & 15, nt = g & 15;
    src = (which == 0 ? F.in[29] : which == 1 ? F.in[31] : F.in[33]) + (size_t)e * D * D + (size_t)kt * 64 * D + nt * 64;
    dst = which == 2 ? (bf16_t*)(F.ws + WS_W2T) + ((size_t)e * 1024 + nt * 64) * 1024 + kt * 64
                     : (bf16_t*)(F.ws + WS_W1T) + ((size_t)e * 2048 + (nt >> 1) * 256 + (which == 1 ? 128 : 0) + (nt & 1) * 64) * 1024 + kt * 64;
}
__device__ __forceinline__ void cq_load(const Frame& F, int g, f4 (&cv)[16]) {
    const float* src; bf16_t* dst; cq_decode(F, g, src, dst);
    const int kb = F.lane >> 4, c4 = (F.lane & 15) * 4;
#pragma unroll
    for (int i = 0; i < 16; ++i) cv[i] = *(const f4*)(src + (size_t)(kb * 16 + i) * D + c4);
}
__device__ __forceinline__ void cq_write(const Frame& F, int g, const f4 (&cv)[16], LAS unsigned char* t) {
    const float* src; bf16_t* dst; cq_decode(F, g, src, dst);
    const int kb = F.lane >> 4, c4 = (F.lane & 15) * 4;
#pragma unroll
    for (int c = 0; c < 4; ++c) { u32x4 w0, w1;
        w0.x = cvt_pk_bf16(cv[0][c], cv[1][c]); w0.y = cvt_pk_bf16(cv[2][c], cv[3][c]); w0.z = cvt_pk_bf16(cv[4][c], cv[5][c]); w0.w = cvt_pk_bf16(cv[6][c], cv[7][c]);
        w1.x = cvt_pk_bf16(cv[8][c], cv[9][c]); w1.y = cvt_pk_bf16(cv[10][c], cv[11][c]); w1.z = cvt_pk_bf16(cv[12][c], cv[13][c]); w1.w = cvt_pk_bf16(cv[14][c], cv[15][c]);
        *(LAS u32x4*)(t + (c4 + c) * CQ_PITCH + kb * 32) = w0; *(LAS u32x4*)(t + (c4 + c) * CQ_PITCH + kb * 32 + 16) = w1; }
    __builtin_amdgcn_wave_barrier(); asm volatile("s_waitcnt lgkmcnt(0)" ::: "memory");
    const int k8 = F.lane & 7, n0 = F.lane >> 3;
#pragma unroll
    for (int j = 0; j < 8; ++j) { const int n = n0 + 8 * j; const u32x4 w = *(LAS u32x4*)(t + n * CQ_PITCH + k8 * 16); *(u32x4*)(dst + (size_t)n * 1024 + k8 * 8) = w; }
    __builtin_amdgcn_wave_barrier();
}
constexpr int SC_TB = 32, SC_STEPS = CTXL + SEQ, SC_NBLK = SC_STEPS / SC_TB;
constexpr int SC_BUF = 5 * SC_TB * 64 + SC_TB * 16 + SC_TB * 2;
__device__ __forceinline__ int scan_blk_row(int b, int dir, int blk) {
    const int p0 = blk * SC_TB;
    if (p0 < CTXL) return NTOK + b * CTXL + (dir ? (CTXL - 1 - p0) : p0);
    const int q = p0 - CTXL; return b * SEQ + (dir ? (SEQ - 1 - q) : q);
}
struct ScanRegs { u32x4 q[5]; u32x4 v; };
__device__ __forceinline__ void unpack8(const u32x4 w, float (&o)[8]) { o[0] = bf_lo(w.x); o[1] = bf_hi(w.x); o[2] = bf_lo(w.y); o[3] = bf_hi(w.y); o[4] = bf_lo(w.z); o[5] = bf_hi(w.z); o[6] = bf_lo(w.w); o[7] = bf_hi(w.w); }
template <int MODE> __device__ __forceinline__ void p_scan(const Frame& F, const bf16_t* R, const bf16_t* A, const bf16_t* V, const bf16_t* LW, const bf16_t* KD, const bf16_t* Bd, bf16_t* Y) {
    for (int u = F.bid; u < NB * NH * 2 * 4; u += F.G) {
        int vs, dir, h, b;
        if (F.G == 256) { vs = (u >> 3) & 3; const int ch = (u & 7) | ((u >> 5) << 3); dir = ch & 1; h = (ch >> 1) & 7; b = ch >> 4; }
        else { vs = u & 3; dir = (u >> 2) & 1; h = (u >> 3) & 7; b = u >> 6; }
        const size_t dofs = (size_t)dir * NROW * RW;
        const bf16_t* arr[5] = {R, LW + dofs, KD + dofs, A, Bd + dofs};
        bf16_t* Yd = Y + (size_t)dir * NTOK * RW;
        const bool comp = F.tid < 256;
        const int lt = F.tid & 255, sgn = dir ? -1 : 1;
        const int vl = lt >> 4, kq = lt & 15;
        const int l_st = lt >> 3, l_oct = lt & 7, l_off = sgn * l_st * RW + h * 64 + l_oct * 8, l_lds = l_st * 64 + l_oct * 8;
        const int v_st = (lt & 63) >> 1, v_hf = lt & 1, v_off = sgn * v_st * RW + h * 64 + vs * 16 + v_hf * 8;
        float S0 = 0.f, S1 = 0.f, S2 = 0.f, S3 = 0.f, yk = 0.f;
        ScanRegs qs[2];
        f4 cv[16];
        const bool do_cvt = (MODE == 0) && (F.G == 256) && (u == F.bid);
        LAS unsigned char* cq_t = F.lds + 2 * SC_BUF * 4 + ((F.wave - 4) & 3) * CQ_BYTES;
#define SC_LOAD(blk_, QS_) do { const size_t rb_ = (size_t)scan_blk_row(b, dir, (blk_)) * RW; _Pragma("unroll") for (int i = 0; i < 5; ++i) QS_.q[i] = *(const u32x4*)(arr[i] + rb_ + l_off); \
            if (lt < 64) QS_.v = *(const u32x4*)(V + rb_ + v_off); } while (0)
#define SC_ST8(buf_, off_, x_) do { *(LAS f4*)&(buf_)[(off_)] = (f4){x_[0], x_[1], x_[2], x_[3]}; *(LAS f4*)&(buf_)[(off_) + 4] = (f4){x_[4], x_[5], x_[6], x_[7]}; } while (0)
#define SC_STORE(buf_, QS_) do { float r_[8], w_[8], k_[8], a_[8], b_[8]; unpack8(QS_.q[0], r_); unpack8(QS_.q[1], w_); unpack8(QS_.q[2], k_); unpack8(QS_.q[3], a_); unpack8(QS_.q[4], b_); \
            float br_ = 0.f, kr_ = 0.f; _Pragma("unroll") for (int j = 0; j < 8; ++j) { w_[j] = __expf(w_[j]); br_ = fmaf(b_[j], r_[j], br_); kr_ = fmaf(k_[j], r_[j], kr_); r_[j] *= w_[j]; } \
            br_ = sum8(br_); kr_ = sum8(kr_); \
            SC_ST8(buf_, 0 * SC_TB * 64 + l_lds, r_); SC_ST8(buf_, 1 * SC_TB * 64 + l_lds, w_); SC_ST8(buf_, 2 * SC_TB * 64 + l_lds, k_); SC_ST8(buf_, 3 * SC_TB * 64 + l_lds, a_); SC_ST8(buf_, 4 * SC_TB * 64 + l_lds, b_); \
            if (l_oct == 0) { (buf_)[5 * SC_TB * 64 + SC_TB * 16 + l_st * 2] = br_; (buf_)[5 * SC_TB * 64 + SC_TB * 16 + l_st * 2 + 1] = kr_; } \
            if (lt < 64) { float v_[8]; unpack8(QS_.v, v_); SC_ST8(buf_, 5 * SC_TB * 64 + v_st * 16 + v_hf * 8, v_); } } while (0)
        __syncthreads();
        if (!comp) { SC_LOAD(0, qs[0]); SC_LOAD(1, qs[1]); SC_STORE(F.sm, qs[0]); SC_LOAD(2, qs[0]); }
        __syncthreads();
        for (int blk0 = 0; blk0 < SC_NBLK; blk0 += 2) {
#pragma unroll
          for (int j3 = 0; j3 < 2; ++j3) {
            const int blk = blk0 + j3;
            if (blk < SC_NBLK) {
            LAS float* cur = F.sm + (blk & 1) * SC_BUF;
            if (!comp) {
                LAS float* nb = F.sm + ((blk + 1) & 1) * SC_BUF;
                if (blk + 1 < SC_NBLK) SC_STORE(nb, qs[(j3 + 1) % 2]);
                if (blk + 3 < SC_NBLK) SC_LOAD(blk + 3, qs[(j3 + 1) % 2]);
                if (do_cvt) { const int jq = blk / 5, ph = blk - jq * 5;
                    if (jq < CQ_PER_WAVE) { const int g = jq * 1024 + F.bid * 4 + (F.wave - 4);
                        if (ph == 3) cq_write(F, g, cv, cq_t);
                        if (ph == 1) cq_load(F, g, cv); } }
            } else {
                const bool emit = blk * SC_TB >= CTXL;
                const int rowb = scan_blk_row(b, dir, blk);
                typedef float f2 __attribute__((ext_vector_type(2)));
#define SC_RD(st_, R01, R23, W01, W23, K01, K23, A01, A23, B01, B23, VV, BR, KR) do { \
                    const f4 r_ = *(LAS f4*)&cur[0 * SC_TB * 64 + (st_) * 64 + kq * 4], w_ = *(LAS f4*)&cur[1 * SC_TB * 64 + (st_) * 64 + kq * 4], k_ = *(LAS f4*)&cur[2 * SC_TB * 64 + (st_) * 64 + kq * 4], \
                             a_ = *(LAS f4*)&cur[3 * SC_TB * 64 + (st_) * 64 + kq * 4], b_ = *(LAS f4*)&cur[4 * SC_TB * 64 + (st_) * 64 + kq * 4]; \
                    R01 = (f2){r_.x, r_.y}; R23 = (f2){r_.z, r_.w}; W01 = (f2){w_.x, w_.y}; W23 = (f2){w_.z, w_.w}; K01 = (f2){k_.x, k_.y}; K23 = (f2){k_.z, k_.w}; \
                    A01 = (f2){a_.x, a_.y}; A23 = (f2){a_.z, a_.w}; B01 = (f2){b_.x, b_.y}; B23 = (f2){b_.z, b_.w}; VV = cur[5 * SC_TB * 64 + (st_) * 16 + vl]; \
                    const f2 sc_ = *(LAS f2*)&cur[5 * SC_TB * 64 + SC_TB * 16 + (st_) * 2]; BR = sc_.x; KR = sc_.y; } while (0)
                f2 S01 = (f2){S0, S1}, S23 = (f2){S2, S3};
                f2 nR01, nR23, nW01, nW23, nK01, nK23, nA01, nA23, nB01, nB23; float nV, nBR, nKR;
                SC_RD(0, nR01, nR23, nW01, nW23, nK01, nK23, nA01, nA23, nB01, nB23, nV, nBR, nKR);
#pragma unroll 1
                for (int half = 0; half < 2; ++half) {
#pragma unroll 4
                    for (int s16 = 0; s16 < 16; ++s16) {
                        const int st = half * 16 + s16;
                        const f2 R01 = nR01, R23 = nR23, W01 = nW01, W23 = nW23, K01 = nK01, K23 = nK23, A01 = nA01, A23 = nA23, B01 = nB01, B23 = nB23; const float vv = nV, brs = nBR, krs = nKR;
                        { const int sn = (st + 1) & (SC_TB - 1); SC_RD(sn, nR01, nR23, nW01, nW23, nK01, nK23, nA01, nA23, nB01, nB23, nV, nBR, nKR); }
                        const f2 sa2 = S01 * A01 + S23 * A23, yp2 = S01 * R01 + S23 * R23;
                        float sa = sa2.x + sa2.y, yp = yp2.x + yp2.y;
                        sa += dpp_f<0xB1>(sa); yp += dpp_f<0xB1>(yp); sa += dpp_f<0x4E>(sa); yp += dpp_f<0x4E>(yp);
                        sa += dpp_f<0x141>(sa); yp += dpp_f<0x141>(yp); sa += dpp_f<0x140>(sa); yp += dpp_f<0x140>(yp);
                        S01 = S01 * W01 + (B01 * sa + K01 * vv); S23 = S23 * W23 + (B23 * sa + K23 * vv);
                        const float y = fmaf(sa, brs, fmaf(vv, krs, yp));
                        yk = (kq == s16) ? y : yk;
                    }
                    if (emit) { const int row = rowb + sgn * (half * 16 + kq); Yd[(size_t)row * RW + h * 64 + vs * 16 + vl] = f2bf(yk); }
                }
                S0 = S01.x; S1 = S01.y; S2 = S23.x; S3 = S23.y;
#undef SC_RD
            }
            }
            __syncthreads();
          }
        }
#undef SC_LOAD
#undef SC_STORE
#undef SC_ST8
    }
}

typedef short bf16x4_t __attribute__((ext_vector_type(4)));
typedef float f32x4_t __attribute__((ext_vector_type(4)));
constexpr int CK_C = 16, CK_NCH = (CTXL + SEQ) / CK_C, CK_BYTES = 12800, CK_TASKS = NB * NH * 2 * CK_NCH;
constexpr size_t WS_FRAG = 292 * MiB;
static_assert(WS_FRAG + (size_t)CK_TASKS * CK_BYTES <= 512 * MiB, "fragment region");
__device__ __forceinline__ bf16x4_t pk4(const f32x4_t x) { u32x2 w; w.x = cvt_pk_bf16(x[0], x[1]); w.y = cvt_pk_bf16(x[2], x[3]); return __builtin_bit_cast(bf16x4_t, w); }
__device__ __forceinline__ bf16x8_t pk8(const f32x4_t lo, const f32x4_t hi) { u32x4 w; w.x = cvt_pk_bf16(lo[0], lo[1]); w.y = cvt_pk_bf16(lo[2], lo[3]); w.z = cvt_pk_bf16(hi[0], hi[1]); w.w = cvt_pk_bf16(hi[2], hi[3]); return __builtin_bit_cast(bf16x8_t, w); }
__device__ __forceinline__ bf16x8_t pk8a(const float* x) { u32x4 w; w.x = cvt_pk_bf16(x[0], x[1]); w.y = cvt_pk_bf16(x[2], x[3]); w.z = cvt_pk_bf16(x[4], x[5]); w.w = cvt_pk_bf16(x[6], x[7]); return __builtin_bit_cast(bf16x8_t, w); }
__device__ __forceinline__ f32x4_t mf32n_(bf16x8_t a, bf16x8_t b, f32x4_t c) { f32x4_t d = __builtin_amdgcn_mfma_f32_16x16x32_bf16(a, b, c, 0, 0, 0); asm volatile("s_nop 7" : "+v"(d)); return d; }
__device__ __forceinline__ f32x4_t mf16n_(bf16x4_t a, bf16x4_t b, f32x4_t c) { f32x4_t d = __builtin_amdgcn_mfma_f32_16x16x16bf16_1k(a, b, c, 0, 0, 0); asm volatile("s_nop 7" : "+v"(d)); return d; }
#define MF32N(a_, b_, c_) mf32n_((a_), (b_), (c_))
#define MF16N(a_, b_, c_) mf16n_((a_), (b_), (c_))
#define MF32(a_, b_, c_) __builtin_amdgcn_mfma_f32_16x16x32_bf16((a_), (b_), (c_), 0, 0, 0)
#define MF16(a_, b_, c_) __builtin_amdgcn_mfma_f32_16x16x16bf16_1k((a_), (b_), (c_), 0, 0, 0)
__device__ __forceinline__ int ck_row(int b, int dir, int p) {
    if (p < CTXL) return NTOK + b * CTXL + (dir ? (CTXL - 1 - p) : p);
    const int q = p - CTXL; return b * SEQ + (dir ? (SEQ - 1 - q) : q);
}
__device__ __forceinline__ void p_chunk_pre(const Frame& F, const bf16_t* R, const bf16_t* A, const bf16_t* LW, const bf16_t* KD, const bf16_t* Bd) {
    const int n = F.lane & 15, g = F.lane >> 4;
    const f32x4_t Z4 = {0.f, 0.f, 0.f, 0.f};
    bf16x8_t bid[2];
    { const int d = n - 4 * g;
#pragma unroll
      for (int hb = 0; hb < 2; ++hb) { u32x4 w = {0u, 0u, 0u, 0u}; if (d >= 0 && d < 4) { const int j = 4 * hb + d; const unsigned one = (j & 1) ? 0x3F800000u : 0x00003F80u; const int wi = j >> 1;
            w.x = wi == 0 ? one : 0u; w.y = wi == 1 ? one : 0u; w.z = wi == 2 ? one : 0u; w.w = wi == 3 ? one : 0u; } bid[hb] = __builtin_bit_cast(bf16x8_t, w); } }
    f32x4_t Idm, mLow, mUp, mUpE;
#pragma unroll
    for (int i = 0; i < 4; ++i) { const int row = 4 * g + i; Idm[i] = row == n ? 1.f : 0.f; mLow[i] = n < row ? 1.f : 0.f; mUp[i] = row < n ? 1.f : 0.f; mUpE[i] = row <= n ? 1.f : 0.f; }
    u32x2 nLW[4], nA[4], nB[4], nK[4], nR[4];
#define CK_IN(task_) do { const int ch_ = (task_) / CK_NCH, c_ = (task_) - ch_ * CK_NCH, dir_ = ch_ & 1; \
        const size_t ro_ = (size_t)ck_row(ch_ >> 4, dir_, c_ * CK_C + n) * RW + ((ch_ >> 1) & 7) * 64 + 4 * g, do_ = (size_t)dir_ * NROW * RW; \
        _Pragma("unroll") for (int t_ = 0; t_ < 4; ++t_) { nLW[t_] = *(const u32x2*)(LW + do_ + ro_ + 16 * t_); nA[t_] = *(const u32x2*)(A + ro_ + 16 * t_); nB[t_] = *(const u32x2*)(Bd + do_ + ro_ + 16 * t_); \
            nK[t_] = *(const u32x2*)(KD + do_ + ro_ + 16 * t_); nR[t_] = *(const u32x2*)(R + ro_ + 16 * t_); } } while (0)
    { const int t0 = F.bid * 8 + F.wave; if (t0 < CK_TASKS) CK_IN(t0); }
    for (int task = F.bid * 8 + F.wave; task < CK_TASKS; task += F.G * 8) {
        float at[16], rt[16], bh[16], kh[16], bc[16], kc[16], gam[16];
        {
            float lwv[16], Lc[16], av[16], bv[16], kv[16], rv[16];
#pragma unroll
            for (int tau = 0; tau < 4; ++tau) {
                lwv[4 * tau] = bf_lo(nLW[tau].x); lwv[4 * tau + 1] = bf_hi(nLW[tau].x); lwv[4 * tau + 2] = bf_lo(nLW[tau].y); lwv[4 * tau + 3] = bf_hi(nLW[tau].y);
                av[4 * tau] = bf_lo(nA[tau].x); av[4 * tau + 1] = bf_hi(nA[tau].x); av[4 * tau + 2] = bf_lo(nA[tau].y); av[4 * tau + 3] = bf_hi(nA[tau].y);
                bv[4 * tau] = bf_lo(nB[tau].x); bv[4 * tau + 1] = bf_hi(nB[tau].x); bv[4 * tau + 2] = bf_lo(nB[tau].y); bv[4 * tau + 3] = bf_hi(nB[tau].y);
                kv[4 * tau] = bf_lo(nK[tau].x); kv[4 * tau + 1] = bf_hi(nK[tau].x); kv[4 * tau + 2] = bf_lo(nK[tau].y); kv[4 * tau + 3] = bf_hi(nK[tau].y);
                rv[4 * tau] = bf_lo(nR[tau].x); rv[4 * tau + 1] = bf_hi(nR[tau].x); rv[4 * tau + 2] = bf_lo(nR[tau].y); rv[4 * tau + 3] = bf_hi(nR[tau].y); }
            { const int tn = task + F.G * 8; if (tn < CK_TASKS) CK_IN(tn); }
#pragma unroll
            for (int e = 0; e < 16; ++e) { float x = lwv[e]; x += dpp_f<0x111>(x); x += dpp_f<0x112>(x); x += dpp_f<0x114>(x); x += dpp_f<0x118>(x); Lc[e] = x; gam[e] = __expf(sum16(lwv[e])); }
#pragma unroll
            for (int e = 0; e < 16; ++e) { const float eL = __expf(Lc[e]), ie = __builtin_amdgcn_rcpf(eL), eX = __expf(Lc[e] - lwv[e]);
                at[e] = av[e] * eX; rt[e] = rv[e] * eL; bh[e] = bv[e] * ie; kh[e] = kv[e] * ie; bc[e] = bh[e] * gam[e]; kc[e] = kh[e] * gam[e]; }
        }
        const bf16x8_t atF0 = pk8a(at), atF1 = pk8a(at + 8), rtF0 = pk8a(rt), rtF1 = pk8a(rt + 8), bhF0 = pk8a(bh), bhF1 = pk8a(bh + 8), khF0 = pk8a(kh), khF1 = pk8a(kh + 8);
        const bf16x8_t bcF0 = pk8a(bc), bcF1 = pk8a(bc + 8), kcF0 = pk8a(kc), kcF1 = pk8a(kc + 8);
        const f32x4_t Ld = MF32N(atF1, bhF1, MF32(atF0, bhF0, Z4)) * mLow;
        const f32x4_t LTd = MF32N(bhF1, atF1, MF32(bhF0, atF0, Z4)) * mUp;
        const f32x4_t Nd = MF32N(atF1, khF1, MF32(atF0, khF0, Z4)) * mLow;
        const f32x4_t QTd = MF32N(bhF1, rtF1, MF32(bhF0, rtF0, Z4)) * mUpE;
        const f32x4_t ZTd = MF32N(khF1, rtF1, MF32(khF0, rtF0, Z4)) * mUpE;
#define CK_PROD(xt_, y_) MF16N(pk4(xt_), pk4(y_), Z4)
        f32x4_t TT;
        { const f32x4_t P2 = CK_PROD(Ld, LTd), P2T = CK_PROD(LTd, Ld);
          const f32x4_t X1 = Idm + LTd, X1T = Idm + Ld;
          const f32x4_t X2 = X1 + CK_PROD(X1T, P2), X2T = X1T + CK_PROD(P2, X1T);
          const f32x4_t P4 = CK_PROD(P2T, P2), P4T = CK_PROD(P2, P2T);
          const f32x4_t X3 = X2 + CK_PROD(X2T, P4), X3T = X2T + CK_PROD(P4, X2T);
          const f32x4_t P8 = CK_PROD(P4T, P4);
          TT = X3 + CK_PROD(X3T, P8); }
        const bf16x4_t TTp = pk4(TT), QTp = pk4(QTd);
        const f32x4_t Mv = MF16N(TTp, pk4(Nd), Z4);
        const bf16x4_t Mvp = pk4(Mv);
        unsigned char* outp = F.ws + WS_FRAG + (size_t)task * CK_BYTES;
        bf16x4_t App[4]; f32x4_t RpT[4];
#pragma unroll
        for (int tau = 0; tau < 4; ++tau) {
            const f32x4_t atK = MF32N(tau < 2 ? atF0 : atF1, bid[tau & 1], Z4);
            const f32x4_t Ap = MF16N(TTp, pk4(atK), Z4);
            App[tau] = pk4(Ap);
            const f32x4_t r0 = {rt[4 * tau], rt[4 * tau + 1], rt[4 * tau + 2], rt[4 * tau + 3]};
            RpT[tau] = MF16N(App[tau], QTp, r0);
        }
        *(bf16x8_t*)(outp + 0 * 1024 + F.lane * 16) = pk8(RpT[0], RpT[1]);
        *(bf16x8_t*)(outp + 1 * 1024 + F.lane * 16) = pk8(RpT[2], RpT[3]);
        *(bf16x4_t*)(outp + 10240 + 0 * 512 + F.lane * 8) = pk4(MF16N(Mvp, QTp, ZTd));
#pragma unroll
        for (int tp = 0; tp < 4; ++tp) {
            const bf16x4_t bcK = pk4(MF32N(tp < 2 ? bcF0 : bcF1, bid[tp & 1], Z4));
            const f32x4_t kcK = MF32N(tp < 2 ? kcF0 : kcF1, bid[tp & 1], Z4);
            f32x4_t Gt[4];
#pragma unroll
            for (int tau = 0; tau < 4; ++tau) { Gt[tau] = MF16N(App[tau], bcK, Z4);
                if (tau == tp) {
#pragma unroll
                    for (int i = 0; i < 4; ++i) Gt[tau][i] += (4 * g + i == n) ? gam[4 * tau + i] : 0.f; } }
            *(bf16x8_t*)(outp + (2 + tp * 2 + 0) * 1024 + F.lane * 16) = pk8(Gt[0], Gt[1]);
            *(bf16x8_t*)(outp + (2 + tp * 2 + 1) * 1024 + F.lane * 16) = pk8(Gt[2], Gt[3]);
            *(bf16x4_t*)(outp + 10240 + (1 + tp) * 512 + F.lane * 8) = pk4(MF16N(Mvp, bcK, kcK));
        }
#undef CK_PROD
    }
#undef CK_IN
}
constexpr int CKR_SLOTS = 8, CKR_VOFF = 13312, CKR_SLOT = 15360, CKR_AHEAD = CKR_SLOTS - 1;
__device__ __forceinline__ void p_chunk_scan(const Frame& F, const bf16_t* V, bf16_t* Y) {
    const int n = F.lane & 15, g = F.lane >> 4;
    const f32x4_t Z4 = {0.f, 0.f, 0.f, 0.f};
    constexpr int CKS_VS = 1, CKS_WG = 4 / CKS_VS;
    for (int u = F.bid; u < NB * NH * 2 * CKS_WG; u += F.G) {
        int chain, vpart;
        if (F.G == 256) { vpart = (u >> 3) % CKS_WG; chain = (u & 7) | ((u / (8 * CKS_WG)) << 3); } else { vpart = u % CKS_WG; chain = u / CKS_WG; }
        const int dir = chain & 1, h = (chain >> 1) & 7, b = chain >> 4;
        const unsigned char* fbase = F.ws + WS_FRAG + (size_t)chain * CK_NCH * CK_BYTES;
        __syncthreads();
        if (F.wave >= 4) {
            const int w = F.wave - 4;
            const int vr = (F.lane >> 3) + 8 * (w & 1);
#define CKR_DMA(c_) do { const unsigned char* p_ = fbase + (size_t)(c_) * CK_BYTES + F.lane * 16; LAS unsigned char* l_ = F.lds + ((c_) & (CKR_SLOTS - 1)) * CKR_SLOT; \
                _Pragma("unroll") for (int i_ = 0; i_ < 4; ++i_) { const int pc_ = i_ < 3 ? i_ * 4 + w : 12; \
                    __builtin_amdgcn_global_load_lds((const unsigned*)(p_ + pc_ * 1024), (LAS unsigned*)(l_ + pc_ * 1024), 16, 0, 0); } \
                __builtin_amdgcn_global_load_lds((const unsigned*)(V + (size_t)ck_row(b, dir, (c_) * CK_C + vr) * RW + h * 64 + (F.lane & 7) * 8), (LAS unsigned*)(l_ + CKR_VOFF + (w & 1) * 1024), 16, 0, 0); } while (0)
#pragma unroll
            for (int c0 = 0; c0 < CKR_AHEAD; ++c0) CKR_DMA(c0);
            for (int c = 0; c < CK_NCH; ++c) {
                if (c + CKR_AHEAD - 1 < CK_NCH) asm volatile("s_waitcnt vmcnt(30)" ::: "memory"); else asm volatile("s_waitcnt vmcnt(0)" ::: "memory");
                __builtin_amdgcn_s_barrier();
                __builtin_amdgcn_s_barrier();
                if (c + CKR_AHEAD < CK_NCH) CKR_DMA(c + CKR_AHEAD);
            }
#undef CKR_DMA
        } else {
            const int vs = vpart * CKS_VS + (F.wave % CKS_VS); const bool act = F.wave < CKS_VS;
            bf16_t* Yd = Y + (size_t)dir * NTOK * RW;
            const size_t vcol = (size_t)h * 64 + vs * 16 + n;
            f32x4_t ST[4] = {Z4, Z4, Z4, Z4};
            for (int c = 0; c < CK_NCH; ++c) {
                const bf16x8_t bS0 = pk8(ST[0], ST[1]), bS1 = pk8(ST[2], ST[3]);
                __builtin_amdgcn_s_barrier();
                LAS unsigned char* sl = F.lds + (c & (CKR_SLOTS - 1)) * CKR_SLOT;
                bf16x8_t f16[10]; bf16x4_t f8[5]; unsigned vq[4];
                if (act) {
#pragma unroll
                for (int i = 0; i < 10; ++i) f16[i] = *(LAS bf16x8_t*)(sl + i * 1024 + F.lane * 16);
#pragma unroll
                for (int i = 0; i < 5; ++i) f8[i] = *(LAS bf16x4_t*)(sl + 10240 + i * 512 + F.lane * 8);
#pragma unroll
                for (int j = 0; j < 4; ++j) vq[j] = *(LAS bf16_t*)(sl + CKR_VOFF + (4 * g + j) * 128 + (vs * 16 + n) * 2);
                }
                asm volatile("s_waitcnt lgkmcnt(0)" ::: "memory");
                __builtin_amdgcn_s_barrier();
                if (act) {
                u32x2 vw; vw.x = vq[0] | (vq[1] << 16); vw.y = vq[2] | (vq[3] << 16); const bf16x4_t VF = __builtin_bit_cast(bf16x4_t, vw);
                if (c >= CTXL / CK_C) {
                    f32x4_t Yc = MF16(f8[0], VF, MF32N(f16[1], bS1, MF32(f16[0], bS0, Z4)));
                    asm volatile("s_nop 7" : "+v"(Yc));
#pragma unroll
                    for (int i = 0; i < 4; ++i) Yd[(size_t)ck_row(b, dir, c * CK_C + 4 * g + i) * RW + vcol] = f2bf(Yc[i]);
                }
#pragma unroll
                for (int tp = 0; tp < 4; ++tp) ST[tp] = MF16(f8[1 + tp], VF, MF32N(f16[3 + 2 * tp], bS1, MF32(f16[2 + 2 * tp], bS0, Z4)));
                asm volatile("s_nop 7" : "+v"(ST[0]), "+v"(ST[1]), "+v"(ST[2]), "+v"(ST[3]));
                }
            }
        }
    }
}
__device__ __forceinline__ void p_readout(const Frame& F, const bf16_t* R, const bf16_t* KD, const bf16_t* V, const bf16_t* G, const bf16_t* Y, bf16_t* Ar) {
    const float* r_k = F.in[16]; const float* gn_w = F.in[17]; const float* gn_b = F.in[18];
    const int c0 = F.lane * 8;
    const f4 rk0 = *(const f4*)(r_k + c0), rk1 = *(const f4*)(r_k + c0 + 4), gw0 = *(const f4*)(gn_w + c0), gw1 = *(const f4*)(gn_w + c0 + 4), gb0 = *(const f4*)(gn_b + c0), gb1 = *(const f4*)(gn_b + c0 + 4);
    const float rk[8] = {rk0.x, rk0.y, rk0.z, rk0.w, rk1.x, rk1.y, rk1.z, rk1.w}, gw[8] = {gw0.x, gw0.y, gw0.z, gw0.w, gw1.x, gw1.y, gw1.z, gw1.w}, gb[8] = {gb0.x, gb0.y, gb0.z, gb0.w, gb1.x, gb1.y, gb1.z, gb1.w};
    for (int row = F.bid * 8 + F.wave; row < NTOK; row += F.G * 8) {
        const size_t o = (size_t)row * RW + c0;
        float y0[8], y1[8], r[8], k0[8], k1[8], v[8], g[8];
        unpack8(*(const u32x4*)(Y + o), y0); unpack8(*(const u32x4*)(Y + (size_t)NTOK * RW + o), y1); unpack8(*(const u32x4*)(R + o), r);
        unpack8(*(const u32x4*)(KD + o), k0); unpack8(*(const u32x4*)(KD + (size_t)NROW * RW + o), k1); unpack8(*(const u32x4*)(V + o), v); unpack8(*(const u32x4*)(G + o), g);
        float sy = 0.f, sb = 0.f;
#pragma unroll
        for (int j = 0; j < 8; ++j) { y0[j] += y1[j]; sy += y0[j]; sb = fmaf(r[j] * (k0[j] + k1[j]), rk[j], sb); }
        const float mu = sum8(sy) * (1.0f / 64.0f), bon = sum8(sb);
        float sq = 0.f;
#pragma unroll
        for (int j = 0; j < 8; ++j) { y0[j] -= mu; sq = fmaf(y0[j], y0[j], sq); }
        const float rs = rsqrtf(sum8(sq) * (1.0f / 64.0f) + 64e-5f);
        float oo[8];
#pragma unroll
        for (int j = 0; j < 8; ++j) oo[j] = (y0[j] * rs * gw[j] + gb[j] + bon * v[j]) * g[j];
        *(u32x4*)(Ar + o) = PK8(oo);
    }
}
__device__ __forceinline__ void moe_table(const Frame& F, LAS int* tb) {
    const unsigned* cnt = (const unsigned*)(F.ws + WS_CTL) + CW_CNT;
    __syncthreads();
    if (F.tid == 0) {
        int ts = 0;
        for (int e = 0; e < NE; ++e) { const int c = (int)cnt[e]; tb[e] = c; tb[32 + e] = ts; ts += (c + 255) / 256; }
        tb[64] = ts; tb[65] = ts;
    }
    __syncthreads();
}
__device__ __forceinline__ void p_final(const Frame& F, const float* x1, const bf16_t* ys) {
    const float* g = F.in[35]; const float* mod = (const float*)(F.ws + WS_MOD);
    for (int row = F.bid * 8 + F.wave; row < NTOK; row += F.G * 8) {
        const float* src = x1 + (size_t)row * D; const int r = row / SEQ;
        f4 v[4]; float ss = 0.f;
#pragma unroll
        for (int i = 0; i < 4; ++i) { const int cidx = i * 256 + F.lane * 4;
            f4 s = (f4){0.f, 0.f, 0.f, 0.f};
#pragma unroll
            for (int k = 0; k < 4; ++k) { const u32x2 y = *(const u32x2*)(ys + ((size_t)row * 4 + k) * D + cidx); s.x += bf_lo(y.x); s.y += bf_hi(y.x); s.z += bf_lo(y.y); s.w += bf_hi(y.y); }
            const f4 ga = *(const f4*)(mod + r * 6144 + 5120 + cidx);
            v[i] = *(const f4*)(src + cidx) + ga * s;
            ss += v[i].x * v[i].x + v[i].y * v[i].y + v[i].z * v[i].z + v[i].w * v[i].w; }
        ss = wave_sum(ss);
        const float rs = rsqrtf(ss * (1.0f / D) + 1e-6f);
#pragma unroll
        for (int i = 0; i < 4; ++i) { const int cidx = i * 256 + F.lane * 4; const f4 gg = *(const f4*)(g + cidx);
            f4 o; o.x = v[i].x * rs * gg.x; o.y = v[i].y * rs * gg.y; o.z = v[i].z * rs * gg.z; o.w = v[i].w * rs * gg.w;
            *(f4*)(F.out + (size_t)row * D + cidx) = o; }
    }
}


typedef short bf16x8_t __attribute__((ext_vector_type(8)));
typedef float f32x16 __attribute__((ext_vector_type(16)));
__device__ __forceinline__ int crow32(int reg, int h) { return (reg & 3) + 8 * (reg >> 2) + 4 * h; }
__device__ __forceinline__ void split_hi_lo(const float (&u)[8], bf16x8_t& hi, bf16x8_t& lo) {
    u32x4 ph, pl;
#pragma unroll
    for (int j = 0; j < 4; ++j) { const unsigned w = cvt_pk_bf16(u[2 * j], u[2 * j + 1]); ph[j] = w;
        pl[j] = cvt_pk_bf16(u[2 * j] - bf_lo(w), u[2 * j + 1] - bf_hi(w)); }
    hi = __builtin_bit_cast(bf16x8_t, ph); lo = __builtin_bit_cast(bf16x8_t, pl);
}
__device__ __forceinline__ void p_cvt_router(const Frame& F) {
    const float* rw = F.in[27]; bf16_t* hi = (bf16_t*)(F.ws + WS_WRT); bf16_t* lo = hi + 32 * 1024;
    for (int idx = F.bid * NT + F.tid; idx < 32 * 1024; idx += F.G * NT) { const int e = idx >> 10, k = idx & 1023; const float v = rw[k * NE + e];
        const unsigned w = cvt_pk_bf16(v, 0.f); hi[idx] = (bf16_t)(w & 0xffffu); lo[idx] = f2bf(v - bf_lo(w)); }
}
__device__ __forceinline__ void p_router_consts(const Frame& F) {
    const float* mod = (const float*)(F.ws + WS_MOD); const float* g = F.in[26]; const float* rw = F.in[27]; const float* rb = F.in[28];
    float* gs2 = (float*)(F.ws + WS_GS2); float* bias2 = (float*)(F.ws + WS_BIAS2);
    if (F.bid == F.G - 1) { for (int i = F.tid; i < 4 * 1024; i += NT) { const int b = i >> 10, k = i & 1023; gs2[i] = g[k] * (1.0f + mod[b * 6144 + 4096 + k]); } }
    if (F.bid == F.G - 2 && F.tid < 128) { const int b = F.tid >> 5, e = F.tid & 31; float a0 = 0.f, a1 = 0.f, a2 = 0.f, a3 = 0.f;
        for (int k = 0; k < 1024; k += 4) { a0 = fmaf(mod[b * 6144 + 3072 + k], rw[k * NE + e], a0); a1 = fmaf(mod[b * 6144 + 3072 + k + 1], rw[(k + 1) * NE + e], a1);
            a2 = fmaf(mod[b * 6144 + 3072 + k + 2], rw[(k + 2) * NE + e], a2); a3 = fmaf(mod[b * 6144 + 3072 + k + 3], rw[(k + 3) * NE + e], a3); }
        bias2[F.tid] = (a0 + a1) + (a2 + a3) + rb[e]; }
}
__device__ __forceinline__ void p_router2(const Frame& F, const float* x1, bf16_t* h2) {
    const float* mod = (const float*)(F.ws + WS_MOD);
    const bf16_t* whi = (const bf16_t*)(F.ws + WS_WRT); const bf16_t* wlo = whi + 32 * 1024;
    const float* gs2 = (const float*)(F.ws + WS_GS2); const float* bias2 = (const float*)(F.ws + WS_BIAS2);
    unsigned* cnt = (unsigned*)(F.ws + WS_CTL) + CW_CNT; int* lst = (int*)(F.ws + WS_LIST); float* wgt = (float*)(F.ws + WS_WGT);
    const int tl = F.wave >> 2, kp = F.wave & 3, r = F.lane & 31, h = F.lane >> 5;
    LAS float* part = F.sm + (tl * 4 + kp) * 1024;
    LAS float* ssq = F.sm + 8192 + (tl * 4 + kp) * 64;
    LAS float* rsv = F.sm + 8192 + 512 + tl * 32;
    LAS float* lg = F.sm + 8192 + 1024 + tl * (32 * 33);
    for (int t0 = F.bid * 2; t0 < NTOK / 32; t0 += F.G * 2) {
        const int row0 = (t0 + tl) * 32, b = row0 / SEQ;
        const float* xr = x1 + (size_t)(row0 + r) * D + kp * 256 + 8 * h;
        const float* gp = gs2 + b * 1024 + kp * 256 + 8 * h;
        const bf16_t* wh = whi + r * 1024 + kp * 256 + 8 * h; const bf16_t* wl = wlo + r * 1024 + kp * 256 + 8 * h;
        f32x16 acc;
#pragma unroll
        for (int i = 0; i < 16; ++i) acc[i] = 0.f;
        float ss = 0.f;
#pragma unroll 4
        for (int ks = 0; ks < 16; ++ks) {
            const f4 x0 = *(const f4*)(xr + ks * 16), x1v = *(const f4*)(xr + ks * 16 + 4), g0 = *(const f4*)(gp + ks * 16), g1 = *(const f4*)(gp + ks * 16 + 4);
            const bf16x8_t bh = *(const bf16x8_t*)(wh + ks * 16), bl = *(const bf16x8_t*)(wl + ks * 16);
            ss += (x0.x * x0.x + x0.y * x0.y) + (x0.z * x0.z + x0.w * x0.w) + (x1v.x * x1v.x + x1v.y * x1v.y) + (x1v.z * x1v.z + x1v.w * x1v.w);
            const float u[8] = {x0.x * g0.x, x0.y * g0.y, x0.z * g0.z, x0.w * g0.w, x1v.x * g1.x, x1v.y * g1.y, x1v.z * g1.z, x1v.w * g1.w};
            bf16x8_t ah, al; split_hi_lo(u, ah, al);
            acc = __builtin_amdgcn_mfma_f32_32x32x16_bf16(ah, bh, acc, 0, 0, 0);
            acc = __builtin_amdgcn_mfma_f32_32x32x16_bf16(al, bh, acc, 0, 0, 0);
            acc = __builtin_amdgcn_mfma_f32_32x32x16_bf16(ah, bl, acc, 0, 0, 0);
        }
        asm volatile("s_nop 15\n\ts_nop 7" : "+v"(acc));
        __syncthreads();
#pragma unroll
        for (int i = 0; i < 16; ++i) part[i * 64 + F.lane] = acc[i];
        ssq[F.lane] = ss;
        __syncthreads();
        if (kp == 0) {
            LAS float* p0 = F.sm + (tl * 4) * 1024; LAS float* q0 = F.sm + 8192 + (tl * 4) * 64;
            float tot = 0.f;
#pragma unroll
            for (int j = 0; j < 4; ++j) tot += q0[j * 64 + r] + q0[j * 64 + r + 32];
            const float rstd = rsqrtf(tot * (1.0f / D) + 1e-6f);
            if (h == 0) rsv[r] = rstd;
            __builtin_amdgcn_wave_barrier(); asm volatile("s_waitcnt lgkmcnt(0)" ::: "memory");
            const float bb = bias2[b * 32 + r];
#pragma unroll
            for (int i = 0; i < 16; ++i) { const float a = (p0[i * 64 + F.lane] + p0[1024 + i * 64 + F.lane]) + (p0[2048 + i * 64 + F.lane] + p0[3072 + i * 64 + F.lane]);
                const int rw_ = crow32(i, h); lg[rw_ * 33 + r] = rsv[rw_] * a + bb; }
            __builtin_amdgcn_wave_barrier(); asm volatile("s_waitcnt lgkmcnt(0)" ::: "memory");
            if (F.lane < 32) {
                float tv[4]; int te[4]; unsigned used = 0u;
#pragma unroll
                for (int k = 0; k < 4; ++k) { float best = -3.0e38f; int bi = 0;
#pragma unroll
                    for (int e = 0; e < 32; ++e) { const float x = lg[F.lane * 33 + e]; if (!((used >> e) & 1u) && x > best) { best = x; bi = e; } }
                    used |= 1u << bi; tv[k] = best; te[k] = bi; }
                float ex[4], sum = 0.f;
#pragma unroll
                for (int k = 0; k < 4; ++k) { ex[k] = expf(tv[k] - tv[0]); sum += ex[k]; }
                const int row = row0 + F.lane;
#pragma unroll
                for (int k = 0; k < 4; ++k) { const unsigned pos = atomicAdd(&cnt[te[k]], 1u); lst[(size_t)te[k] * ECAP + pos] = row * 4 + k; wgt[row * 4 + k] = ex[k] / sum; }
            }
        }
        __syncthreads();
#pragma unroll 2
        for (int i = 0; i < 8; ++i) { const int rl = kp * 8 + i, row = row0 + rl; const float rstd = rsv[rl];
#pragma unroll
            for (int j = 0; j < 4; ++j) { const int c = j * 256 + F.lane * 4;
                const f4 x = *(const f4*)(x1 + (size_t)row * D + c), gg = *(const f4*)(gs2 + b * 1024 + c), sh = *(const f4*)(mod + b * 6144 + 3072 + c);
                u32x2 o; o.x = cvt_pk_bf16(x.x * rstd * gg.x + sh.x, x.y * rstd * gg.y + sh.y); o.y = cvt_pk_bf16(x.z * rstd * gg.z + sh.z, x.w * rstd * gg.w + sh.w);
                *(u32x2*)(h2 + (size_t)row * D + c) = o; } }
    }
}
constexpr int SG_PITCH = 272;
__device__ __forceinline__ void p_sgu2(const Frame& F, const bf16_t* Gs, bf16_t* As_) {
    const float* lnw = F.in[20]; const float* lnb = F.in[21]; const float* Wsp = F.in[22]; const float* bsp = F.in[23];
    LAS unsigned char* zt = F.lds;
    const int r = F.lane & 31, h = F.lane >> 5;
    for (int u = F.bid; u < NB * 32 * 2; u += F.G) {
        const int gh = u & 1, n = (u >> 1) & 31, b = u >> 6;
        const int row0 = b * SEQ + n * 128;
        __syncthreads();
        for (int p = F.wave; p < 128; p += 8) {
            const u32x4 zw = *(const u32x4*)(Gs + (size_t)(row0 + p) * 1024 + 512 + F.lane * 8);
            float z[8] = {bf_lo(zw.x), bf_hi(zw.x), bf_lo(zw.y), bf_hi(zw.y), bf_lo(zw.z), bf_hi(zw.z), bf_lo(zw.w), bf_hi(zw.w)};
            float sm_ = 0.f;
#pragma unroll
            for (int j = 0; j < 8; ++j) sm_ += z[j];
            const float mu = wave_sum(sm_) * (1.0f / 512.0f);
            float q = 0.f;
#pragma unroll
            for (int j = 0; j < 8; ++j) { const float d = z[j] - mu; q += d * d; }
            const float rs = rsqrtf(wave_sum(q) * (1.0f / 512.0f) + 1e-5f);
            if ((F.lane >> 5) == gh) { const int cl = (F.lane & 31) * 8, ch = F.lane * 8;
#pragma unroll
                for (int j = 0; j < 8; ++j) *(LAS bf16_t*)(zt + (cl + j) * SG_PITCH + p * 2) = f2bf((z[j] - mu) * rs * lnw[ch + j] + lnb[ch + j]); }
        }
        __syncthreads();
        const int ct = F.wave & 1, pt = F.wave >> 1;
#pragma unroll 1
        for (int gl = 0; gl < 4; ++gl) {
            const int g = gh * 4 + gl;
            f32x16 acc;
#pragma unroll
            for (int i = 0; i < 16; ++i) acc[i] = 0.f;
            const float* wp = Wsp + ((size_t)g * 128 + pt * 32 + r) * 128 + 8 * h;
            LAS unsigned char* ap = zt + (gl * 64 + ct * 32 + r) * SG_PITCH + 16 * h;
#pragma unroll
            for (int ks = 0; ks < 8; ++ks) {
                const bf16x8_t a = *(LAS bf16x8_t*)(ap + ks * 32);
                const f4 w0 = *(const f4*)(wp + ks * 16), w1 = *(const f4*)(wp + ks * 16 + 4);
                u32x4 bw; bw.x = cvt_pk_bf16(w0.x, w0.y); bw.y = cvt_pk_bf16(w0.z, w0.w); bw.z = cvt_pk_bf16(w1.x, w1.y); bw.w = cvt_pk_bf16(w1.z, w1.w);
                acc = __builtin_amdgcn_mfma_f32_32x32x16_bf16(a, __builtin_bit_cast(bf16x8_t, bw), acc, 0, 0, 0);
            }
            asm volatile("s_nop 15\n\ts_nop 7" : "+v"(acc));
            const int p = pt * 32 + r, row = row0 + p; const float bias = bsp[g * 128 + p];
#pragma unroll
            for (int q4 = 0; q4 < 4; ++q4) { const int c = ct * 32 + 8 * q4 + 4 * h;
                const u32x2 uw = *(const u32x2*)(Gs + (size_t)row * 1024 + g * 64 + c);
                u32x2 o; o.x = cvt_pk_bf16(bf_lo(uw.x) * (acc[q4 * 4 + 0] + bias), bf_hi(uw.x) * (acc[q4 * 4 + 1] + bias));
                o.y = cvt_pk_bf16(bf_lo(uw.y) * (acc[q4 * 4 + 2] + bias), bf_hi(uw.y) * (acc[q4 * 4 + 3] + bias));
                *(u32x2*)(As_ + (size_t)row * RW + g * 64 + c) = o; }
        }
    }
}

constexpr int LDS_BYTES = mg::STAGE_BYTES + 4096;
constexpr int N_PHASES = 16;

__global__ void __launch_bounds__(NT, 2) fwd_kernel(Args args) {
    extern __shared__ __attribute__((aligned(16))) unsigned char lds_raw[];
    Frame F;
    F.in = args.in; F.out = args.out; F.ws = args.ws;
    F.sm = (LAS float*)lds_raw; F.lds = (LAS unsigned char*)lds_raw;
    F.tid = threadIdx.x; F.lane = F.tid & 63; F.wave = __builtin_amdgcn_readfirstlane(F.tid >> 6); F.G = gridDim.x; F.bid = blockIdx.x;
    volatile LAS unsigned* xbw = (volatile LAS unsigned*)(lds_raw + LDS_BYTES - 16);
    LAS int* tb = (LAS int*)(lds_raw + mg::STAGE_BYTES);
    if (F.tid == 0) { xbw[0] = 0u; xbw[1] = 0u; xbw[2] = 0u; xbw[3] = 0u; }
    __syncthreads();
    XcdBarrier bar = xcd_barrier_post((unsigned*)(F.ws + WS_CTL), xbw);
    const int lo = args.ph_lo, hi = args.ph_hi;
#ifndef PH_MASK
#define PH_MASK 0xFFFFFFFFu
#endif
#define IN(k) (((PH_MASK >> (k)) & 1u) && lo <= (k) && (k) < hi)
#define SEAM(k) do { if (IN(k) && IN((k) + 1)) xcd_barrier(bar); } while (0)
    unsigned char* ws = F.ws;
    float* mod = (float*)(ws + WS_MOD);
    bf16_t* Hb = (bf16_t*)(ws + WS_H); bf16_t* Prw = (bf16_t*)(ws + WS_PRW); bf16_t* GateA = (bf16_t*)(ws + WS_GA); bf16_t* Gsgu = (bf16_t*)(ws + WS_GSGU); bf16_t* GateB = (bf16_t*)(ws + WS_GB);
    bf16_t* Asg = (bf16_t*)(ws + WS_AS); bf16_t* Mb = (bf16_t*)(ws + WS_M);
    bf16_t* Rr = (bf16_t*)(ws + WS_R); bf16_t* LW = (bf16_t*)(ws + WS_LW); bf16_t* Kraw = (bf16_t*)(ws + WS_KRAW); bf16_t* Alora = (bf16_t*)(ws + WS_ALORA);
    bf16_t* Aa = (bf16_t*)(ws + WS_A); bf16_t* Vv = (bf16_t*)(ws + WS_V); bf16_t* KD = (bf16_t*)(ws + WS_KD); bf16_t* Bd = (bf16_t*)(ws + WS_B); bf16_t* Gg = (bf16_t*)(ws + WS_G);
    bf16_t* Yd = (bf16_t*)(ws + WS_YD); bf16_t* Arb = (bf16_t*)(ws + WS_AR);
    float* X1 = (float*)(ws + WS_X1); bf16_t* H2 = (bf16_t*)(ws + WS_H2); bf16_t* Act = (bf16_t*)(ws + WS_ACT);
    bf16_t* W1t = (bf16_t*)(ws + WS_W1T); bf16_t* W2t = (bf16_t*)(ws + WS_W2T); bf16_t* Ys = (bf16_t*)(ws + WS_W1T);
    const int* lst = (const int*)(ws + WS_LIST); const float* wgt = (const float*)(ws + WS_WGT);

    if (IN(0)) { p_mod(F); p_cvt_small(F); p_cvt_router(F); p_cvt_lora(F); }
    SEAM(0);
    if (IN(1)) { p_router_consts(F); p_norm1(F, Hb); }
    SEAM(1);
    if (IN(2)) { mg::PProb P{Hb, (const bf16_t*)(ws + WS_WINT), F.G, F.bid}; mg::EpiP E{Prw, Gsgu, GateA, GateB}; mg::gemm_run(F.lds, P, E); }
    SEAM(2);
    if (IN(3)) p_sgu2(F, Gsgu, Asg);
    SEAM(3);
    if (IN(4)) { mg::DenseProb P{Asg, (const bf16_t*)(ws + WS_WOS), 64, 4, 512, F.G, F.bid}; mg::EpiGateMul<false> E{Mb, GateB}; mg::gemm_run(F.lds, P, E); }
    SEAM(4);
    if (IN(5)) p_prepA(F, Prw, Rr, Kraw, Vv, Aa, Alora);
    SEAM(5);
    if (IN(6)) { mg::DenseProb P{Alora, (const bf16_t*)(ws + WS_LORAT), 68, 10, 384, F.G, F.bid}; mg::EpiLora E{LW, KD, Bd, Gg, Kraw, Aa, F.in[9], F.in[11], F.in[15]}; mg::gemm_run(F.lds, P, E); }
    SEAM(6);
#ifdef USE_SEQ_SCAN
    if (IN(7)) p_scan<0>(F, Rr, Aa, Vv, LW, KD, Bd, Yd);
#else
    if (IN(7)) { p_chunk_pre(F, Rr, Aa, LW, KD, Bd); xcd_barrier(bar); p_chunk_scan(F, Vv, Yd); }
#endif
    SEAM(7);
    if (IN(8)) p_readout(F, Rr, KD, Vv, Gg, Yd, Arb);
    SEAM(8);
    if (IN(9)) { mg::DenseProb P{Arb, (const bf16_t*)(ws + WS_WOR), 64, 4, 512, F.G, F.bid}; mg::EpiGateMul<true> E{Mb, GateA}; mg::gemm_run(F.lds, P, E); }
    SEAM(9);
    if (IN(10)) { mg::DenseProb P{Mb, (const bf16_t*)(ws + WS_WOT), 64, 4, 1024, F.G, F.bid}; mg::EpiX1 E{X1, F.in[0], mod}; mg::gemm_run(F.lds, P, E); }
    SEAM(10);
#ifdef USE_SEQ_SCAN
    if (IN(11)) { p_router2(F, X1, H2); if (F.G != 256) p_cvt_experts(F); }
#else
    if (IN(11)) { p_router2(F, X1, H2); p_cvt_experts(F); }
#endif
    SEAM(11);
    if (IN(12)) { moe_table(F, tb); mg::Moe1Prob P{H2, W1t, lst, tb, F.G, F.bid}; mg::EpiMoe1 E{Act, F.in[30], F.in[32]}; mg::gemm_run(F.lds, P, E); }
    SEAM(12);
    if (IN(13)) { moe_table(F, tb); mg::Moe2Prob P{Act, W2t, tb, F.G, F.bid}; mg::EpiMoe2 E{Ys, F.in[34], lst, wgt, tb}; mg::gemm_run(F.lds, P, E); }
    SEAM(13);
    if (IN(14)) p_final(F, X1, Ys);
#undef IN
#undef SEAM
}

extern "C" void kernel_launch(void* const* d_in, const int* in_sizes, int n_in, void* d_out, int out_size, void* d_ws, size_t ws_size, hipStream_t stream) {
    static int grid = 0;
    if (grid == 0) {
        if (n_in != 36 || out_size != NTOK * D || ws_size < WS_END) { fprintf(stderr, "kernel_launch: unexpected shapes (n_in %d out %d ws %zu, need %zu)\n", n_in, out_size, ws_size, (size_t)WS_END); grid = -1; return; }
        int dev = 0, cus = 0, per_cu = 0;
        if (hipGetDevice(&dev) != hipSuccess || hipDeviceGetAttribute(&cus, hipDeviceAttributeMultiprocessorCount, dev) != hipSuccess) { grid = -1; return; }
        if (hipFuncSetAttribute((const void*)fwd_kernel, hipFuncAttributeMaxDynamicSharedMemorySize, LDS_BYTES) != hipSuccess) { grid = -1; return; }
        if (hipOccupancyMaxActiveBlocksPerMultiprocessor(&per_cu, (const void*)fwd_kernel, NT, LDS_BYTES) != hipSuccess || per_cu < 1) { fprintf(stderr, "occupancy query: %d\n", per_cu); }
        (void)hipGetLastError();
        grid = cus;
    }
    if (grid < 0) return;
    (void)hipMemsetAsync((char*)d_ws + WS_CTL, 0, CTL_BYTES + 131072, stream);
    Args a{};
    for (int i = 0; i < 36; ++i) a.in[i] = (const float*)d_in[i];
    a.out = (float*)d_out; a.ws = (unsigned char*)d_ws; a.ph_lo = 0; a.ph_hi = N_PHASES;
    hipLaunchKernelGGL(fwd_kernel, dim3(grid), dim3(NT), LDS_BYTES, stream, a);
}
```

```cpp
#include <hip/hip_runtime.h>
#include <cstdio>
#include <cstdint>

#define XB_TMO      128
#define XB_XCNT(j)  (256  + 64 * (j))
#define XB_XSUB(j)  (1280 + 64 * (j))
#define XB_XGEN(j)  (2304 + 64 * (j))
#define XB_TOP      3328
#define XB_TOPGEN   3392
#define XCD_BAR_WORDS 3456
#define XB_SPIN_CAP (1u << 21)
#define LAS __attribute__((address_space(3)))

__device__ __forceinline__ unsigned xb_ld(unsigned* p)              { return __hip_atomic_load(p, __ATOMIC_RELAXED, __HIP_MEMORY_SCOPE_AGENT); }
__device__ __forceinline__ unsigned xb_add(unsigned* p, unsigned v) { return __hip_atomic_fetch_add(p, v, __ATOMIC_RELAXED, __HIP_MEMORY_SCOPE_AGENT); }
__device__ __forceinline__ unsigned xb_xcc_id() { return (unsigned)__builtin_amdgcn_s_getreg((3 << 11) | 20) & 0xFu; }
#define XB_SPIN(cond, bar) do { unsigned _sp = 0; while (cond) { __builtin_amdgcn_s_sleep(1); \
    if ((++_sp & 255u) == 0u) { if (xb_ld(&(bar)[XB_TMO])) break; if (_sp > XB_SPIN_CAP) { atomicAdd(&(bar)[XB_TMO], 1u); break; } } } } while (0)

struct XcdBarrier {
    unsigned* bar; unsigned x;
    volatile LAS unsigned* st;
};

__device__ __forceinline__ XcdBarrier xcd_barrier_post(unsigned* bar, volatile LAS unsigned* st) {
    XcdBarrier b; b.bar = bar; b.x = xb_xcc_id(); b.st = st;
    if (threadIdx.x == 0) (void)xb_add(&bar[XB_XCNT(b.x)], 1u);
    return b;
}
__device__ __forceinline__ void xcd_barrier_complete(unsigned* bar, unsigned x, unsigned& nloc, unsigned& nx) {
    const unsigned G = gridDim.x * gridDim.y * gridDim.z;
    unsigned sum, cnt, mine, sp = 0u;
    for (;;) {
        sum = 0u; cnt = 0u; mine = 0u;
#pragma unroll
        for (unsigned j = 0; j < 16; ++j) { const unsigned c = xb_ld(&bar[XB_XCNT(j)]); sum += c; cnt += (c > 0u) ? 1u : 0u; mine = (j == x) ? c : mine; }
        if (sum == G) break;
        __builtin_amdgcn_s_sleep(1);
        if ((++sp & 255u) == 0u) { if (xb_ld(&bar[XB_TMO])) break; if (sp > XB_SPIN_CAP) { atomicAdd(&bar[XB_TMO], 1u); break; } }
    }
    nloc = mine > 0u ? mine : 1u; nx = cnt > 0u ? cnt : 1u;
}

__device__ __forceinline__ void xcd_barrier(const XcdBarrier& b) {
    asm volatile("s_waitcnt vmcnt(0)" ::: "memory");
    __syncthreads();
    if (threadIdx.x == 0) {
        unsigned* bar = b.bar;
        __builtin_amdgcn_s_waitcnt(0);
        unsigned nloc = b.st[0], nx = b.st[1];
        if (nloc == 0u) { xcd_barrier_complete(bar, b.x, nloc, nx); b.st[0] = nloc; b.st[1] = nx; }
        const unsigned old = xb_add(&bar[XB_XSUB(b.x)], 1u);
        const unsigned gen = old / nloc;
        if (old + 1u == (gen + 1u) * nloc) {
            __builtin_amdgcn_fence(__ATOMIC_RELEASE, "agent");
            asm volatile("s_waitcnt vmcnt(0)" ::: "memory");
            const unsigned og = xb_add(&bar[XB_TOP], 1u);
            const unsigned tg = og / nx;
            if (og + 1u == (tg + 1u) * nx) xb_add(&bar[XB_TOPGEN], 1u);
            else XB_SPIN(xb_ld(&bar[XB_TOPGEN]) == tg, bar);
            __builtin_amdgcn_fence(__ATOMIC_ACQUIRE, "agent");
            xb_add(&bar[XB_XGEN(b.x)], 1u);
            asm volatile("s_waitcnt vmcnt(0)" ::: "memory");
        } else {
            XB_SPIN(xb_ld(&bar[XB_XGEN(b.x)]) == gen, bar);
            __builtin_amdgcn_fence(__ATOMIC_ACQUIRE, "agent");
            asm volatile("s_waitcnt vmcnt(0)" ::: "memory");
        }
    }
    __syncthreads();
}

constexpr int D = 1024, NB = 4, SEQ = 4096, NTOK = NB * SEQ, CTXL = 256, NCTX = NB * CTXL, NROW = NTOK + NCTX;
constexpr int RW = 512, NH = 8, HD = 64, RCOLS = 1920, INC = 4992, PRW_LD = 2048;
constexpr int NE = 32, TOPK = 4, ECAP = NTOK;
constexpr int NT = 512;
typedef float f4 __attribute__((ext_vector_type(4)));
typedef unsigned short bf16_t;
typedef unsigned u32x2 __attribute__((ext_vector_type(2)));
typedef unsigned u32x4 __attribute__((ext_vector_type(4)));
typedef short bf16x8_t __attribute__((ext_vector_type(8)));

typedef float f32x2_cv __attribute__((ext_vector_type(2)));
typedef __bf16 bf16x2_cv __attribute__((ext_vector_type(2)));
__device__ __forceinline__ unsigned cvt_pk_bf16(float lo, float hi) { return __builtin_bit_cast(unsigned, __builtin_convertvector((f32x2_cv){lo, hi}, bf16x2_cv)); }
__device__ __forceinline__ float bf_lo(unsigned w) { return __uint_as_float(w << 16); }
__device__ __forceinline__ float bf_hi(unsigned w) { return __uint_as_float(w & 0xffff0000u); }
__device__ __forceinline__ float bf2f(bf16_t b) { return __uint_as_float(((unsigned)b) << 16); }
__device__ __forceinline__ bf16_t f2bf(float f) { return (bf16_t)(cvt_pk_bf16(f, 0.f) & 0xffffu); }

constexpr size_t MiB = 1024 * 1024;
constexpr size_t WS_CTL = 0;
constexpr size_t CTL_BYTES = 65536;
constexpr size_t WS_MOD = WS_CTL + CTL_BYTES;
constexpr size_t WS_LIST = WS_MOD + 131072;
constexpr size_t WS_WGT = WS_LIST + (size_t)NE * ECAP * 4;
constexpr size_t WS_POS = 2 * MiB + 512 * 1024;
constexpr size_t WS_WRT = 3 * MiB;
constexpr size_t WS_GS2 = WS_WRT + 131072, WS_BIAS2 = WS_GS2 + 16384;
constexpr size_t WS_WINT = 4 * MiB;
constexpr size_t WS_WOR = 14 * MiB;
constexpr size_t WS_WOS = 15 * MiB;
constexpr size_t WS_WOT = 16 * MiB;
constexpr size_t WS_LORAT = 18 * MiB;
constexpr size_t WS_GA = 20 * MiB;
constexpr size_t WS_GSGU = 52 * MiB;
constexpr size_t WS_H = 84 * MiB;
constexpr size_t WS_PRW = 118 * MiB;
constexpr size_t WS_LW = 118 * MiB, WS_GB = 118 * MiB, WS_KD = 152 * MiB, WS_M = 152 * MiB;
constexpr size_t WS_R = 186 * MiB, WS_A = 203 * MiB, WS_AS = 203 * MiB;
constexpr size_t WS_B = 220 * MiB, WS_YD = 220 * MiB;
constexpr size_t WS_G = 254 * MiB, WS_V = 271 * MiB;
constexpr size_t WS_KRAW = 300 * MiB, WS_ALORA = 317 * MiB;
constexpr size_t WS_AR = 288 * MiB;
constexpr size_t WS_X1 = 52 * MiB, WS_H2 = 20 * MiB, WS_ACT = 148 * MiB;
constexpr size_t WS_SSP = 84 * MiB;
constexpr int CS_TILES = 64;
constexpr size_t WS_W1T = 384 * MiB;
constexpr size_t WS_END = 512 * MiB;
constexpr int CW_CNT = 4096;
constexpr int ACT_ROWS = 65536 + 32 * 256;
static_assert(XCD_BAR_WORDS <= CW_CNT, "ctl layout");
static_assert(WS_WGT + 65536 * 4 <= WS_POS && WS_POS + 65536 * 4 <= WS_WRT && WS_BIAS2 + 512 <= WS_WINT, "misc region");
static_assert((size_t)ACT_ROWS * 1024 * 2 <= 144 * MiB, "act region");

struct Args { const float* in[36]; float* out; unsigned char* ws; int ph_lo, ph_hi; };
struct Frame { const float* const* in; float* out; unsigned char* ws; LAS float* sm; LAS unsigned char* lds; int tid, lane, wave, G, bid; };

template <int CTRL> __device__ __forceinline__ float dpp_f(float x) { return __int_as_float(__builtin_amdgcn_update_dpp(0, __float_as_int(x), CTRL, 0xF, 0xF, false)); }
__device__ __forceinline__ float sum8(float x) { x += dpp_f<0xB1>(x); x += dpp_f<0x4E>(x); x += dpp_f<0x141>(x); return x; }
__device__ __forceinline__ float sum16(float x) { x = sum8(x); x += dpp_f<0x140>(x); return x; }
__device__ __forceinline__ float wave_sum(float v) {
    v = sum16(v);
    const int iv = __float_as_int(v);
    const float r0 = __int_as_float(__builtin_amdgcn_readlane(iv, 0)), r1 = __int_as_float(__builtin_amdgcn_readlane(iv, 16));
    const float r2 = __int_as_float(__builtin_amdgcn_readlane(iv, 32)), r3 = __int_as_float(__builtin_amdgcn_readlane(iv, 48));
    return (r0 + r1) + (r2 + r3);
}
__device__ __forceinline__ float sigmoid_acc(float x) { return 1.0f / (1.0f + expf(-x)); }
__device__ __forceinline__ float sigmoid_fast(float x) { return __builtin_amdgcn_rcpf(1.0f + __expf(-x)); }

namespace mg {
typedef short bf16x8 __attribute__((ext_vector_type(8)));
typedef float f32x4 __attribute__((ext_vector_type(4)));
typedef float f32x2 __attribute__((ext_vector_type(2)));
constexpr int BM = 256, BK = 64, HALF = 128, HTB = HALF * BK * 2, STAGE_BYTES = 8 * HTB, NXCD = 8, WGM = 8;
__device__ __forceinline__ int lds_byte(int r, int c) { const int st = (r >> 4) * 2 + (c >> 5), rr = r & 15, cc = c & 31, ob = rr * 64 + cc * 2; return st * 1024 + (ob ^ (((ob >> 9) & 1) << 5)); }
__device__ __forceinline__ void stage_rc(int b, int& R, int& C) { const int st = b / 1024, sb = b % 1024, swz = sb ^ (((sb >> 9) & 1) << 5); R = (st >> 1) * 16 + swz / 64; C = (st & 1) * 32 + (swz % 64) / 2; }
__device__ __forceinline__ int perm32(int rho) { const int n = rho >> 4, i = rho & 15; return 8 * (i >> 2) + 4 * n + (i & 3); }
struct Unit { int pm, pn, e, li; };

__device__ __forceinline__ f32x2 gelu_pk(f32x2 v) {
    const f32x2 av = __builtin_elementwise_abs(v), d = av * 0.2316418882f + 1.0f;
    f32x2 t; t.x = __builtin_amdgcn_rcpf(d.x); t.y = __builtin_amdgcn_rcpf(d.y);
    f32x2 q = t * 0.5307027145f + (-0.7265760135f); q = q * t + 0.7107068705f; q = q * t + (-0.142248368f); q = q * t + 0.127414796f; q = q * t;
    const f32x2 s = (v * v) * (-0.72134752044f);
    f32x2 e; e.x = __builtin_amdgcn_exp2f(s.x); e.y = __builtin_amdgcn_exp2f(s.y);
    const f32x2 m = v * (q * e), r = v - m;
    f32x2 o; o.x = v.x < 0.f ? m.x : r.x; o.y = v.y < 0.f ? m.y : r.y; return o;
}

__device__ __forceinline__ bool static_order(int L, int nM, int nN, Unit& u) {
    const int nwg = nM * nN; if (L >= nwg) return false;
    int wgid = L; { const int q = nwg / NXCD, r = nwg % NXCD, xcd = wgid % NXCD, off = wgid / NXCD; wgid = (xcd < r ? xcd * (q + 1) : r * (q + 1) + (xcd - r) * q) + off; }
    const int nig = WGM * nN, gid = wgid / nig, fm = gid * WGM, gsz = (nM - fm) < WGM ? (nM - fm) : WGM;
    u.pm = fm + ((wgid % nig) % gsz); u.pn = (wgid % nig) / gsz; u.e = 0; u.li = 0; return true;
}

template <class Prob, class Epi>
__device__ __forceinline__ void gemm_run(LAS unsigned char* lds, const Prob& P, const Epi& E) {
    const int tid = threadIdx.x, wid = __builtin_amdgcn_readfirstlane(tid >> 6), lane = tid & 63, wr = wid >> 2, wc = wid & 3, fr = lane & 15, fq = lane >> 4;
    const int K = P.K, nt = K / BK, ldb = P.ldb();
    int sR[2], sC[2]; unsigned voffB[2];
#pragma unroll
    for (int i = 0; i < 2; ++i) { int R, C; stage_rc(tid * 16 + i * 8192, R, C); sR[i] = R; sC[i] = C; const int Rb = Epi::PERM ? ((R & ~31) + perm32(R & 31)) : R; voffB[i] = (unsigned)(Rb * ldb + C) * 2u; }
    const size_t kstep = (size_t)(BK * 2);
    const size_t hstep = (size_t)HALF * ldb * 2;
    const unsigned ldsw = (unsigned)wid * 1024u;
    const int aoff = lds_byte(wr * 64 + fr, fq * 8), boff = lds_byte(wc * 32 + fr, fq * 8);
#define MG_SA(b, h) (((b) * 2 + (h)) * HTB)
#define MG_SB(b, h) ((4 + (b) * 2 + (h)) * HTB)
#define MG_STAGE(bufoff, gbase, voff) do { _Pragma("unroll") for (int _i = 0; _i < 2; ++_i) \
        __builtin_amdgcn_global_load_lds((const unsigned*)((const char*)(gbase) + (voff)[_i]), (LAS unsigned*)(lds + (bufoff) + ldsw + _i * 8192), 16, 0, 0); } while (0)
#define MG_LDA(dst, b, h) do { _Pragma("unroll") for (int m = 0; m < 4; ++m) _Pragma("unroll") for (int k = 0; k < 2; ++k) dst[m][k] = *(const LAS bf16x8*)(lds + MG_SA(b, h) + aoff + m * 2048 + k * 1024); } while (0)
#define MG_LDB(dst, b, h) do { _Pragma("unroll") for (int n = 0; n < 2; ++n) _Pragma("unroll") for (int k = 0; k < 2; ++k) dst[n][k] = *(const LAS bf16x8*)(lds + MG_SB(b, h) + boff + n * 2048 + k * 1024); } while (0)
#define MG_MMA(ai, bj, At, Bt) do { __builtin_amdgcn_s_setprio(1); _Pragma("unroll") for (int m = 0; m < 4; ++m) _Pragma("unroll") for (int n = 0; n < 2; ++n) _Pragma("unroll") for (int k = 0; k < 2; ++k) \
        acc[ai][bj][m][n] = __builtin_amdgcn_mfma_f32_16x16x32_bf16(Bt[n][k], At[m][k], acc[ai][bj][m][n], 0, 0, 0); __builtin_amdgcn_s_setprio(0); } while (0)
#define MG_WAIT_V(n) asm volatile("s_waitcnt vmcnt(" #n ")" ::: "memory")
#define MG_WAIT_L(n) asm volatile("s_waitcnt lgkmcnt(" #n ")" ::: "memory")
#define MG_BAR __builtin_amdgcn_s_barrier()
#define MG_SCHED __builtin_amdgcn_sched_barrier(0)
    Unit cur, nxt; int ui = 0;
    if (!P.next(0, cur)) return;
    f32x4 acc[2][2][4][2];
#pragma unroll
    for (int a = 0; a < 2; ++a)
#pragma unroll
        for (int b = 0; b < 2; ++b)
#pragma unroll
            for (int m = 0; m < 4; ++m)
#pragma unroll
                for (int n = 0; n < 2; ++n) acc[a][b][m][n] = (f32x4){0.f, 0.f, 0.f, 0.f};
    bf16x8 At[4][2], B0[2][2], B1[2][2];
    unsigned aoC[2][2], aoN[2][2];
    P.a_offs(cur, sR, sC, aoC);
    const char* const Ab = P.a_base();
    const char* cB = P.b_base(cur);
    MG_STAGE(MG_SB(0, 0), cB, voffB); MG_STAGE(MG_SA(0, 0), Ab, aoC[0]); MG_STAGE(MG_SB(0, 1), cB + hstep, voffB); MG_STAGE(MG_SA(0, 1), Ab, aoC[1]);
    if (wr == 1) MG_BAR;
    MG_WAIT_V(4); MG_BAR;
    MG_STAGE(MG_SB(1, 0), cB + kstep, voffB); MG_STAGE(MG_SA(1, 0), Ab + kstep, aoC[0]); MG_STAGE(MG_SB(1, 1), cB + hstep + kstep, voffB);
    MG_WAIT_V(6); MG_BAR;
    for (;;) {
        const bool has_next = P.next(ui + 1, nxt);
        const char* nB = cB;
        if (has_next) { P.a_offs(nxt, sR, sC, aoN); nB = P.b_base(nxt); }
        else { aoN[0][0] = aoC[0][0]; aoN[0][1] = aoC[0][1]; aoN[1][0] = aoC[1][0]; aoN[1][1] = aoC[1][1]; }
        for (int t = 0; t < nt; t += 2) {
            const bool last = (t == nt - 2);
            const char* a1 = Ab + (size_t)(t + 1) * kstep;
            const char* a2 = last ? Ab : Ab + (size_t)(t + 2) * kstep; const char* b2 = last ? nB : cB + (size_t)(t + 2) * kstep;
            const char* a3 = a2 + kstep; const char* b3 = b2 + kstep;
            unsigned o0[2], o1[2];
            o0[0] = last ? aoN[0][0] : aoC[0][0]; o0[1] = last ? aoN[0][1] : aoC[0][1]; o1[0] = last ? aoN[1][0] : aoC[1][0]; o1[1] = last ? aoN[1][1] : aoC[1][1];
            MG_LDB(B0, 0, 0); MG_SCHED; MG_LDA(At, 0, 0); MG_STAGE(MG_SA(1, 1), a1, aoC[1]);
            MG_WAIT_L(8); MG_BAR; MG_WAIT_L(0); MG_MMA(0, 0, At, B0); MG_BAR; MG_SCHED;
            MG_LDB(B1, 0, 1); MG_STAGE(MG_SB(0, 0), b2, voffB);
            MG_BAR; MG_WAIT_L(0); MG_MMA(0, 1, At, B1); MG_BAR;
            MG_LDA(At, 0, 1); MG_STAGE(MG_SA(0, 0), a2, o0);
            MG_BAR; MG_WAIT_L(0); MG_MMA(1, 0, At, B0); MG_BAR; MG_SCHED;
            MG_STAGE(MG_SB(0, 1), b2 + hstep, voffB);
            MG_WAIT_V(6); MG_BAR; MG_MMA(1, 1, At, B1); MG_BAR;
            MG_LDB(B0, 1, 0); MG_SCHED; MG_LDA(At, 1, 0); MG_STAGE(MG_SA(0, 1), a2, o1);
            MG_WAIT_L(8); MG_BAR; MG_WAIT_L(0); MG_MMA(0, 0, At, B0); MG_BAR; MG_SCHED;
            MG_LDB(B1, 1, 1); MG_STAGE(MG_SB(1, 0), b3, voffB);
            MG_BAR; MG_WAIT_L(0); MG_MMA(0, 1, At, B1); MG_BAR;
            MG_LDA(At, 1, 1); MG_STAGE(MG_SA(1, 0), a3, o0);
            MG_BAR; MG_WAIT_L(0); MG_MMA(1, 0, At, B0); MG_BAR; MG_SCHED;
            MG_STAGE(MG_SB(1, 1), b3 + hstep, voffB);
            MG_WAIT_V(6); MG_BAR; MG_MMA(1, 1, At, B1); MG_BAR;
        }
        MG_SCHED; asm volatile("s_nop 15\n\ts_nop 7" ::: "memory"); MG_SCHED;
        E(acc, cur, wr, wc, fr, fq);
        if (!has_next) break;
#pragma unroll
        for (int a = 0; a < 2; ++a)
#pragma unroll
            for (int b = 0; b < 2; ++b)
#pragma unroll
                for (int m = 0; m < 4; ++m)
#pragma unroll
                    for (int n = 0; n < 2; ++n) acc[a][b][m][n] = (f32x4){0.f, 0.f, 0.f, 0.f};
        cur = nxt; cB = nB; ++ui;
        aoC[0][0] = aoN[0][0]; aoC[0][1] = aoN[0][1]; aoC[1][0] = aoN[1][0]; aoC[1][1] = aoN[1][1];
    }
    MG_WAIT_V(0);
    if (wr == 0) MG_BAR;
    MG_BAR;
#undef MG_SA
#undef MG_SB
#undef MG_STAGE
#undef MG_LDA
#undef MG_LDB
#undef MG_MMA
#undef MG_WAIT_V
#undef MG_WAIT_L
#undef MG_BAR
#undef MG_SCHED
}

struct DenseProb {
    const bf16_t* A; const bf16_t* Bt; int nM, nN, K, G, c;
    __device__ __forceinline__ int ldb() const { return K; }
    __device__ __forceinline__ bool next(int i, Unit& u) const { return static_order(i * G + c, nM, nN, u); }
    __device__ __forceinline__ const char* a_base() const { return (const char*)A; }
    __device__ __forceinline__ const char* b_base(const Unit& u) const { return (const char*)Bt + (size_t)u.pn * BM * K * 2; }
    __device__ __forceinline__ void a_offs(const Unit& u, const int (&sR)[2], const int (&sC)[2], unsigned (&o)[2][2]) const {
#pragma unroll
        for (int h = 0; h < 2; ++h)
#pragma unroll
            for (int i = 0; i < 2; ++i) o[h][i] = (unsigned)((u.pm * BM + h * HALF + sR[i]) * K + sC[i]) * 2u; }
};
struct PProb {
    const bf16_t* A; const bf16_t* Bt; int G, c; static constexpr int K = 1024;
    __device__ __forceinline__ int ldb() const { return K; }
    __device__ __forceinline__ bool next(int i, Unit& u) const { const int L = i * G + c; if (L < 1024) return static_order(L, 64, 16, u);
        if (L >= 1056) return false; const int t = L - 1024; u.pm = 64 + (t >> 3); u.pn = t & 7; u.e = 0; u.li = 0; return true; }
    __device__ __forceinline__ const char* a_base() const { return (const char*)A; }
    __device__ __forceinline__ const char* b_base(const Unit& u) const { return (const char*)Bt + (size_t)u.pn * BM * K * 2; }
    __device__ __forceinline__ void a_offs(const Unit& u, const int (&sR)[2], const int (&sC)[2], unsigned (&o)[2][2]) const {
#pragma unroll
        for (int h = 0; h < 2; ++h)
#pragma unroll
            for (int i = 0; i < 2; ++i) o[h][i] = (unsigned)((u.pm * BM + h * HALF + sR[i]) * K + sC[i]) * 2u; }
};
struct YYProb {
    const bf16_t* As; const bf16_t* Ar; const bf16_t* WoS; const bf16_t* WoR; int G, c; static constexpr int K = 512;
    __device__ __forceinline__ int ldb() const { return K; }
    __device__ __forceinline__ bool next(int i, Unit& u) const { if (i >= 2) return false; if (!static_order(c, 64, 4, u)) return false; u.e = i; u.li = i; return true; }
    __device__ __forceinline__ const char* a_base() const { return (const char*)As; }
    __device__ __forceinline__ const char* b_base(const Unit& u) const { return (const char*)(u.e ? WoR : WoS) + (size_t)u.pn * BM * K * 2; }
    __device__ __forceinline__ void a_offs(const Unit& u, const int (&sR)[2], const int (&sC)[2], unsigned (&o)[2][2]) const {
        const unsigned d = u.e ? (unsigned)((const char*)Ar - (const char*)As) : 0u;
#pragma unroll
        for (int h = 0; h < 2; ++h)
#pragma unroll
            for (int i = 0; i < 2; ++i) o[h][i] = d + (unsigned)((u.pm * BM + h * HALF + sR[i]) * K + sC[i]) * 2u; }
};
struct LoraProb {
    const bf16_t* A; const bf16_t* Bt; int G, c; static constexpr int K = 128;
    __device__ __forceinline__ int ldb() const { return 384; }
    __device__ __forceinline__ bool next(int i, Unit& u) const { return static_order(i * G + c, 68, 10, u); }
    __device__ __forceinline__ int koff(const Unit& u) const { return u.pn < 4 ? 0 : (u.pn < 8 ? 128 : 256); }
    __device__ __forceinline__ const char* a_base() const { return (const char*)A; }
    __device__ __forceinline__ const char* b_base(const Unit& u) const { return (const char*)Bt + ((size_t)u.pn * BM * 384 + koff(u)) * 2; }
    __device__ __forceinline__ void a_offs(const Unit& u, const int (&sR)[2], const int (&sC)[2], unsigned (&o)[2][2]) const {
        const int ko = koff(u);
#pragma unroll
        for (int h = 0; h < 2; ++h)
#pragma unroll
            for (int i = 0; i < 2; ++i) o[h][i] = (unsigned)((u.pm * BM + h * HALF + sR[i]) * 384 + ko + sC[i]) * 2u; }
};
__device__ __forceinline__ int moe_expert_of(LAS const int* tb, int rt) { int e = 0;
#pragma unroll
    for (int i = 1; i < NE; ++i) e = (tb[32 + i] <= rt) ? i : e;
    return e; }
struct Moe1Prob {
    const bf16_t* H2; const bf16_t* W1t; const int* lst; LAS const int* tb; LAS const int* tok; int G, c, i_lo, i_hi; static constexpr int K = 1024;
    __device__ __forceinline__ int ldb() const { return K; }
    __device__ __forceinline__ bool next(int i_, Unit& u) const { const int RT = tb[65]; int rt, ct; const int i = i_lo + i_; if (i >= i_hi) return false;
        if (G == 256) { const int xcd = c & 7, r = c >> 3, s = i * 8 + xcd; rt = 4 * s + (r & 3); ct = r >> 2; } else { const int L = i * G + c; rt = L >> 3; ct = L & 7; }
        if (rt >= RT) return false; u.pm = rt; u.pn = ct; u.e = moe_expert_of(tb, rt); u.li = i_; return true; }
    __device__ __forceinline__ const char* a_base() const { return (const char*)H2; }
    __device__ __forceinline__ const char* b_base(const Unit& u) const { return (const char*)W1t + ((size_t)u.e * 2048 + (size_t)u.pn * 256) * K * 2; }
    __device__ __forceinline__ void a_offs(const Unit& u, const int (&sR)[2], const int (&sC)[2], unsigned (&o)[2][2]) const {
#pragma unroll
        for (int h = 0; h < 2; ++h)
#pragma unroll
            for (int i = 0; i < 2; ++i) o[h][i] = (unsigned)(tok[u.li * 256 + h * HALF + sR[i]] * K + sC[i]) * 2u; }
    __device__ __forceinline__ void fill(LAS int* tw, int* pos) const {
        Unit u;
        for (int i = 0; next(i, u); ++i) { if (i >= 12) break;
            const int g0 = (u.pm - tb[32 + u.e]) * 256, cnt = tb[u.e];
            if (threadIdx.x < 256) { const int gi = g0 + threadIdx.x; int tk = 0; if (gi < cnt) { const int as = lst[(size_t)u.e * ECAP + gi]; tk = as >> 2; if (u.pn == 0) pos[as] = u.pm * 256 + threadIdx.x; } tw[i * 256 + threadIdx.x] = tk; } }
        __syncthreads(); }
};
struct Moe2Prob {
    const bf16_t* Act; const bf16_t* W2t; LAS const int* tb; int G, c, s0, single; static constexpr int K = 1024;
    __device__ __forceinline__ int ldb() const { return K; }
    __device__ __forceinline__ bool next(int i, Unit& u) const { const int RT = tb[65]; int rt, ct;
        if (single >= 0) { if (i > 0) return false; const int sB = single >> 5, q = single & 31; rt = 8 * sB + (q & 7); ct = q >> 3; }
        else if (G == 256) { const int xcd = c & 7, r = c >> 3, s = s0 + i * 8 + xcd; rt = 8 * s + (r & 7); ct = r >> 3; } else { const int L = s0 * 32 + i * G + c; rt = L >> 2; ct = L & 3; }
        if (rt >= RT) return false; u.pm = rt; u.pn = ct; u.e = moe_expert_of(tb, rt); u.li = i; return true; }
    __device__ __forceinline__ const char* a_base() const { return (const char*)Act; }
    __device__ __forceinline__ const char* b_base(const Unit& u) const { return (const char*)W2t + ((size_t)u.e * 1024 + (size_t)u.pn * 256) * K * 2; }
    __device__ __forceinline__ void a_offs(const Unit& u, const int (&sR)[2], const int (&sC)[2], unsigned (&o)[2][2]) const {
#pragma unroll
        for (int h = 0; h < 2; ++h)
#pragma unroll
            for (int i = 0; i < 2; ++i) o[h][i] = (unsigned)((u.pm * BM + h * HALF + sR[i]) * K + sC[i]) * 2u; }
};

struct EpiP {
    static constexpr bool PERM = true;
    bf16_t* Prw; bf16_t* Gsgu; bf16_t* GateA;
    __device__ __forceinline__ void operator()(const f32x4 (&acc)[2][2][4][2], const Unit& u, int wr, int wc, int fr, int fq) const {
        const int row0 = u.pm * BM + wr * 64 + fr, colt = wc * 32 + 8 * fq;
        bf16_t* base; int ld, mode;
        if (u.pn < 8) { base = Prw + u.pn * 256; ld = PRW_LD; mode = 0; }
        else if (u.pn < 12) { base = Gsgu + (u.pn - 8) * 256; ld = 1024; mode = 1; }
        else { base = GateA + (u.pn - 12) * 256; ld = 1024; mode = 2; }
#pragma unroll
        for (int ai = 0; ai < 2; ++ai)
#pragma unroll
            for (int m = 0; m < 4; ++m) { bf16_t* rowp = base + (size_t)(row0 + ai * HALF + m * 16) * ld + colt;
#pragma unroll
                for (int bj = 0; bj < 2; ++bj) { f32x4 v0 = acc[ai][bj][m][0], v1 = acc[ai][bj][m][1];
                    if (mode == 1) { const f32x2 a = gelu_pk((f32x2){v0[0], v0[1]}), b = gelu_pk((f32x2){v0[2], v0[3]}), c = gelu_pk((f32x2){v1[0], v1[1]}), d = gelu_pk((f32x2){v1[2], v1[3]});
                        v0 = (f32x4){a.x, a.y, b.x, b.y}; v1 = (f32x4){c.x, c.y, d.x, d.y}; }
                    if (mode == 2) {
#pragma unroll
                        for (int j = 0; j < 4; ++j) { v0[j] = sigmoid_fast(v0[j]); v1[j] = sigmoid_fast(v1[j]); } }
                    u32x4 w; w.x = cvt_pk_bf16(v0[0], v0[1]); w.y = cvt_pk_bf16(v0[2], v0[3]); w.z = cvt_pk_bf16(v1[0], v1[1]); w.w = cvt_pk_bf16(v1[2], v1[3]);
                    *(u32x4*)(rowp + bj * HALF) = w; } }
    }
};
struct EpiSig {
    static constexpr bool PERM = true;
    bf16_t* O;
    __device__ __forceinline__ void operator()(const f32x4 (&acc)[2][2][4][2], const Unit& u, int wr, int wc, int fr, int fq) const {
        const int row0 = u.pm * BM + wr * 64 + fr, col0 = u.pn * BM + wc * 32 + 8 * fq;
#pragma unroll
        for (int ai = 0; ai < 2; ++ai)
#pragma unroll
            for (int m = 0; m < 4; ++m) { bf16_t* rowp = O + (size_t)(row0 + ai * HALF + m * 16) * 1024 + col0;
#pragma unroll
                for (int bj = 0; bj < 2; ++bj) { f32x4 v0 = acc[ai][bj][m][0], v1 = acc[ai][bj][m][1];
#pragma unroll
                    for (int j = 0; j < 4; ++j) { v0[j] = sigmoid_fast(v0[j]); v1[j] = sigmoid_fast(v1[j]); }
                    u32x4 w; w.x = cvt_pk_bf16(v0[0], v0[1]); w.y = cvt_pk_bf16(v0[2], v0[3]); w.z = cvt_pk_bf16(v1[0], v1[1]); w.w = cvt_pk_bf16(v1[2], v1[3]);
                    *(u32x4*)(rowp + bj * HALF) = w; } }
    }
};
template <bool ACCUM> struct EpiGateMul {
    static constexpr bool PERM = true;
    bf16_t* Mo; const bf16_t* gate;
    __device__ __forceinline__ void operator()(const f32x4 (&acc)[2][2][4][2], const Unit& u, int wr, int wc, int fr, int fq) const {
        const int row0 = u.pm * BM + wr * 64 + fr, col0 = u.pn * BM + wc * 32 + 8 * fq;
#pragma unroll
        for (int ai = 0; ai < 2; ++ai)
#pragma unroll
            for (int m = 0; m < 4; ++m) { const size_t ro = (size_t)(row0 + ai * HALF + m * 16) * 1024 + col0;
#pragma unroll
                for (int bj = 0; bj < 2; ++bj) { const f32x4 v0 = acc[ai][bj][m][0], v1 = acc[ai][bj][m][1];
                    const u32x4 g = *(const u32x4*)(gate + ro + bj * HALF);
                    float o[8] = {bf_lo(g.x) * v0[0], bf_hi(g.x) * v0[1], bf_lo(g.y) * v0[2], bf_hi(g.y) * v0[3], bf_lo(g.z) * v1[0], bf_hi(g.z) * v1[1], bf_lo(g.w) * v1[2], bf_hi(g.w) * v1[3]};
                    if (ACCUM) { const u32x4 p = *(const u32x4*)(Mo + ro + bj * HALF);
                        o[0] += bf_lo(p.x); o[1] += bf_hi(p.x); o[2] += bf_lo(p.y); o[3] += bf_hi(p.y); o[4] += bf_lo(p.z); o[5] += bf_hi(p.z); o[6] += bf_lo(p.w); o[7] += bf_hi(p.w); }
                    u32x4 w; w.x = cvt_pk_bf16(o[0], o[1]); w.y = cvt_pk_bf16(o[2], o[3]); w.z = cvt_pk_bf16(o[4], o[5]); w.w = cvt_pk_bf16(o[6], o[7]);
                    *(u32x4*)(Mo + ro + bj * HALF) = w; } }
    }
};
struct EpiYY {
    static constexpr bool PERM = true;
    bf16_t* Mo; const bf16_t* gateA; const bf16_t* gateB;
    __device__ __forceinline__ void operator()(const f32x4 (&acc)[2][2][4][2], const Unit& u, int wr, int wc, int fr, int fq) const {
        if (u.e == 0) { EpiGateMul<false> E{Mo, gateB}; E(acc, u, wr, wc, fr, fq); } else { EpiGateMul<true> E{Mo, gateA}; E(acc, u, wr, wc, fr, fq); }
    }
};
struct EpiX1 {
    static constexpr bool PERM = true;
    bf16_t* x1; const float* x; const float* mod; float* ssp;
    __device__ __forceinline__ void operator()(const f32x4 (&acc)[2][2][4][2], const Unit& u, int wr, int wc, int fr, int fq) const {
        const int row0 = u.pm * BM + wr * 64 + fr, col0 = u.pn * BM + wc * 32 + 8 * fq;
        const float* gp = mod + (size_t)((u.pm * BM) / SEQ) * 6144 + 2048 + col0;
        f32x4 gv[2][2];
#pragma unroll
        for (int bj = 0; bj < 2; ++bj)
#pragma unroll
            for (int n = 0; n < 2; ++n) gv[bj][n] = *(const f32x4*)(gp + bj * HALF + 4 * n);
#pragma unroll
        for (int ai = 0; ai < 2; ++ai)
#pragma unroll
            for (int m = 0; m < 4; ++m) { const size_t ro = (size_t)(row0 + ai * HALF + m * 16) * D + col0; float sq = 0.f;
#pragma unroll
                for (int bj = 0; bj < 2; ++bj) { const f32x4 x0 = *(const f32x4*)(x + ro + bj * HALF), x1v = *(const f32x4*)(x + ro + bj * HALF + 4);
                    const f32x4 o0 = x0 + gv[bj][0] * acc[ai][bj][m][0], o1 = x1v + gv[bj][1] * acc[ai][bj][m][1];
                    sq += ((o0[0] * o0[0] + o0[1] * o0[1]) + (o0[2] * o0[2] + o0[3] * o0[3])) + ((o1[0] * o1[0] + o1[1] * o1[1]) + (o1[2] * o1[2] + o1[3] * o1[3]));
                    u32x4 w; w.x = cvt_pk_bf16(o0[0], o0[1]); w.y = cvt_pk_bf16(o0[2], o0[3]); w.z = cvt_pk_bf16(o1[0], o1[1]); w.w = cvt_pk_bf16(o1[2], o1[3]);
                    *(u32x4*)(x1 + ro + bj * HALF) = w; }
                sq += __shfl_xor(sq, 16); sq += __shfl_xor(sq, 32);
                if (fq == 0) ssp[(size_t)(row0 + ai * HALF + m * 16) * 16 + u.pn * 4 + wc] = sq; }
    }
};
struct EpiMoe1 {
    static constexpr bool PERM = true;
    bf16_t* act; const float* bg; const float* bu;
    __device__ __forceinline__ void operator()(const f32x4 (&acc)[2][2][4][2], const Unit& u, int wr, int wc, int fr, int fq) const {
        const int row0 = u.pm * BM + wr * 64 + fr, col0 = u.pn * 128 + wc * 32 + 8 * fq;
        f32x4 bgv[2], buv[2];
#pragma unroll
        for (int n = 0; n < 2; ++n) { bgv[n] = *(const f32x4*)(bg + u.e * 1024 + col0 + 4 * n); buv[n] = *(const f32x4*)(bu + u.e * 1024 + col0 + 4 * n); }
#pragma unroll
        for (int ai = 0; ai < 2; ++ai)
#pragma unroll
            for (int m = 0; m < 4; ++m) { float o[8];
#pragma unroll
                for (int n = 0; n < 2; ++n) { const f32x4 g4 = acc[ai][0][m][n] + bgv[n], u4 = acc[ai][1][m][n] + buv[n];
#pragma unroll
                    for (int j = 0; j < 4; ++j) { const float g = fminf(g4[j], 7.0f), uu = fminf(fmaxf(u4[j], -7.0f), 7.0f); o[n * 4 + j] = g * sigmoid_fast(1.702f * g) * (uu + 1.0f); } }
                u32x4 w; w.x = cvt_pk_bf16(o[0], o[1]); w.y = cvt_pk_bf16(o[2], o[3]); w.z = cvt_pk_bf16(o[4], o[5]); w.w = cvt_pk_bf16(o[6], o[7]);
                *(u32x4*)(act + (size_t)(row0 + ai * HALF + m * 16) * 1024 + col0) = w; }
    }
};
struct EpiMoe2 {
    static constexpr bool PERM = true;
    bf16_t* ys; const float* bd;
    __device__ __forceinline__ void operator()(const f32x4 (&acc)[2][2][4][2], const Unit& u, int wr, int wc, int fr, int fq) const {
        const int row0 = u.pm * BM + wr * 64 + fr, col0 = u.pn * BM + wc * 32 + 8 * fq;
        f32x4 bv[2][2];
#pragma unroll
        for (int bj = 0; bj < 2; ++bj)
#pragma unroll
            for (int n = 0; n < 2; ++n) bv[bj][n] = *(const f32x4*)(bd + u.e * 1024 + col0 + bj * HALF + 4 * n);
#pragma unroll
        for (int ai = 0; ai < 2; ++ai)
#pragma unroll
            for (int m = 0; m < 4; ++m) { bf16_t* rowp = ys + (size_t)(row0 + ai * HALF + m * 16) * 1024 + col0;
#pragma unroll
                for (int bj = 0; bj < 2; ++bj) { const f32x4 v0 = acc[ai][bj][m][0] + bv[bj][0], v1 = acc[ai][bj][m][1] + bv[bj][1];
                    u32x4 o; o.x = cvt_pk_bf16(v0[0], v0[1]); o.y = cvt_pk_bf16(v0[2], v0[3]); o.z = cvt_pk_bf16(v1[0], v1[1]); o.w = cvt_pk_bf16(v1[2], v1[3]);
                    *(u32x4*)(rowp + bj * HALF) = o; } }
    }
};
template <class Prob> __device__ __forceinline__ void moe2_fill(const Prob& P, LAS const int* tb, const int* lst, const float* wgt, LAS int* tw) {
    Unit u;
    for (int i = 0; P.next(i, u); ++i) { if (i >= 6) break;
        const int g0 = (u.pm - tb[32 + u.e]) * 256, cnt = tb[u.e];
        if (threadIdx.x < 256) { const int gi = g0 + threadIdx.x; int as = -1; float w = 0.f; if (gi < cnt) { as = lst[(size_t)u.e * ECAP + gi]; w = wgt[as]; }
            tw[(i * 256 + threadIdx.x) * 2] = as; tw[(i * 256 + threadIdx.x) * 2 + 1] = __float_as_int(w); } }
    __syncthreads(); }
struct EpiLora {
    static constexpr bool PERM = true;
    bf16_t* LW; bf16_t* KD; bf16_t* Bd; bf16_t* G; const bf16_t* Kraw; const bf16_t* A; const float* w0; const float* a0; const float* k_a;
    __device__ __forceinline__ void operator()(const f32x4 (&acc)[2][2][4][2], const Unit& u, int wr, int wc, int fr, int fq) const {
        const int row0 = u.pm * BM + wr * 64 + fr, ch0 = (u.pn & 1) * 256 + wc * 32 + 8 * fq, type = u.pn >> 1, d = type & 1;
        const size_t dofs = (size_t)d * NROW * RW;
#pragma unroll
        for (int bj = 0; bj < 2; ++bj) { const int ch = ch0 + bj * HALF;
            if (type < 2) { const f32x4 wv0 = *(const f32x4*)(w0 + d * RW + ch), wv1 = *(const f32x4*)(w0 + d * RW + ch + 4);
#pragma unroll
                for (int ai = 0; ai < 2; ++ai)
#pragma unroll
                    for (int m = 0; m < 4; ++m) { const f32x4 x0 = acc[ai][bj][m][0] + wv0, x1 = acc[ai][bj][m][1] + wv1; float o[8];
#pragma unroll
                        for (int j = 0; j < 4; ++j) { o[j] = -0.6065306597f * sigmoid_fast(x0[j]); o[4 + j] = -0.6065306597f * sigmoid_fast(x1[j]); }
                        u32x4 w; w.x = cvt_pk_bf16(o[0], o[1]); w.y = cvt_pk_bf16(o[2], o[3]); w.z = cvt_pk_bf16(o[4], o[5]); w.w = cvt_pk_bf16(o[6], o[7]);
                        *(u32x4*)(LW + dofs + (size_t)(row0 + ai * HALF + m * 16) * RW + ch) = w; }
            } else if (type < 4) { const f32x4 av0 = *(const f32x4*)(a0 + d * RW + ch), av1 = *(const f32x4*)(a0 + d * RW + ch + 4), ka0 = *(const f32x4*)(k_a + ch), ka1 = *(const f32x4*)(k_a + ch + 4);
#pragma unroll
                for (int ai = 0; ai < 2; ++ai) {
                    u32x4 kw[4], aw[4];
#pragma unroll
                    for (int m = 0; m < 4; ++m) { const size_t ro = (size_t)(row0 + ai * HALF + m * 16) * RW + ch; kw[m] = *(const u32x4*)(Kraw + ro); aw[m] = *(const u32x4*)(A + ro); }
#pragma unroll
                    for (int m = 0; m < 4; ++m) { const size_t ro = (size_t)(row0 + ai * HALF + m * 16) * RW + ch;
                        const f32x4 x0 = acc[ai][bj][m][0] + av0, x1 = acc[ai][bj][m][1] + av1; const u32x4 kww = kw[m], aww = aw[m];
                        const float kr[8] = {bf_lo(kww.x), bf_hi(kww.x), bf_lo(kww.y), bf_hi(kww.y), bf_lo(kww.z), bf_hi(kww.z), bf_lo(kww.w), bf_hi(kww.w)};
                        const float na[8] = {bf_lo(aww.x), bf_hi(aww.x), bf_lo(aww.y), bf_hi(aww.y), bf_lo(aww.z), bf_hi(aww.z), bf_lo(aww.w), bf_hi(aww.w)};
                        float okd[8], ob[8];
#pragma unroll
                        for (int j = 0; j < 4; ++j) { const float s0 = sigmoid_fast(x0[j]), s1 = sigmoid_fast(x1[j]);
                            okd[j] = kr[j] * (1.0f + (s0 - 1.0f) * ka0[j]); ob[j] = -na[j] * s0; okd[4 + j] = kr[4 + j] * (1.0f + (s1 - 1.0f) * ka1[j]); ob[4 + j] = -na[4 + j] * s1; }
                        u32x4 w1, w2; w1.x = cvt_pk_bf16(okd[0], okd[1]); w1.y = cvt_pk_bf16(okd[2], okd[3]); w1.z = cvt_pk_bf16(okd[4], okd[5]); w1.w = cvt_pk_bf16(okd[6], okd[7]);
                        w2.x = cvt_pk_bf16(ob[0], ob[1]); w2.y = cvt_pk_bf16(ob[2], ob[3]); w2.z = cvt_pk_bf16(ob[4], ob[5]); w2.w = cvt_pk_bf16(ob[6], ob[7]);
                        *(u32x4*)(KD + dofs + ro) = w1; *(u32x4*)(Bd + dofs + ro) = w2; }
                }
            } else {
#pragma unroll
                for (int ai = 0; ai < 2; ++ai)
#pragma unroll
                    for (int m = 0; m < 4; ++m) { const f32x4 x0 = acc[ai][bj][m][0], x1 = acc[ai][bj][m][1];
                        u32x4 w; w.x = cvt_pk_bf16(x0[0], x0[1]); w.y = cvt_pk_bf16(x0[2], x0[3]); w.z = cvt_pk_bf16(x1[0], x1[1]); w.w = cvt_pk_bf16(x1[2], x1[3]);
                        *(u32x4*)(G + (size_t)(row0 + ai * HALF + m * 16) * RW + ch) = w; }
            } }
    }
};
}

constexpr int CV_LDB = 272;
__device__ __forceinline__ void cvt_tile(const Frame& F, const float* src, int ldw, bf16_t* dst, int ldd) {
    LAS unsigned char* ts = F.lds;
    const int nq = F.tid & 31, kg = F.tid >> 5;
    f4 v[8];
#pragma unroll
    for (int j = 0; j < 8; ++j) v[j] = *(const f4*)(src + (size_t)(kg * 8 + j) * ldw + nq * 4);
    __syncthreads();
#pragma unroll
    for (int c = 0; c < 4; ++c) { u32x4 w; w.x = cvt_pk_bf16(v[0][c], v[1][c]); w.y = cvt_pk_bf16(v[2][c], v[3][c]); w.z = cvt_pk_bf16(v[4][c], v[5][c]); w.w = cvt_pk_bf16(v[6][c], v[7][c]);
        *(LAS u32x4*)(ts + (nq * 4 + c) * CV_LDB + kg * 16) = w; }
    __syncthreads();
#pragma unroll
    for (int it = 0; it < 4; ++it) { const int slot = it * NT + F.tid, kq = slot & 15, n = slot >> 4;
        const u32x4 w = *(LAS u32x4*)(ts + n * CV_LDB + kq * 16);
        *(u32x4*)(dst + (size_t)n * ldd + kq * 8) = w; }
}
__device__ __forceinline__ void p_cvt_small(const Frame& F) {
    bf16_t* WinT = (bf16_t*)(F.ws + WS_WINT); bf16_t* WoR = (bf16_t*)(F.ws + WS_WOR); bf16_t* WoS = (bf16_t*)(F.ws + WS_WOS); bf16_t* WoT = (bf16_t*)(F.ws + WS_WOT);
    for (int t = F.bid; t < 312 + 32 + 32 + 64; t += F.G) {
        if (t < 312) { const int kt = t / 39, ntl = t % 39, n0 = ntl * 128, r0 = n0 < 1920 ? n0 : n0 + 128;
            cvt_tile(F, F.in[7] + (size_t)kt * 128 * INC + n0, INC, WinT + (size_t)r0 * 1024 + kt * 128, 1024); }
        else if (t < 376) { const int j = (t - 312) & 31, kt = j >> 3, ntl = j & 7; const bool sg = t >= 344;
            cvt_tile(F, (sg ? F.in[24] : F.in[19]) + (size_t)kt * 128 * 1024 + ntl * 128, 1024, (sg ? WoS : WoR) + (size_t)ntl * 128 * 512 + kt * 128, 512); }
        else { const int j = t - 376, kt = j >> 3, ntl = j & 7;
            cvt_tile(F, F.in[25] + (size_t)kt * 128 * 1024 + ntl * 128, 1024, WoT + (size_t)ntl * 128 * 1024 + kt * 128, 1024); }
    }
}
__device__ __forceinline__ void p_cvt_experts(const Frame& F) {
    bf16_t* W1t = (bf16_t*)(F.ws + WS_W1T); bf16_t* W2t = (bf16_t*)F.out;
    for (int t = F.bid; t < (CS_TILES == 128 ? 16 : NE) * 128; t += F.G) {
        const int e = t >> 7, j = t & 127, which = j >> 6, kt = (j & 63) >> 3, ntl = j & 7;
        const float* src = (which == 0 ? F.in[29] : which == 1 ? F.in[31] : F.in[33]) + (size_t)e * D * D + (size_t)kt * 128 * D + ntl * 128;
        bf16_t* dst = which == 2 ? W2t + ((size_t)e * 1024 + ntl * 128) * 1024 + kt * 128
                                 : W1t + ((size_t)e * 2048 + ntl * 256 + (which == 1 ? 128 : 0)) * 1024 + kt * 128;
        cvt_tile(F, src, D, dst, 1024);
    }
}

__device__ __forceinline__ void p_mod(const Frame& F) {
    const float* c = F.in[1]; const float* cc = F.in[3]; const float* w = F.in[4]; const float* b = F.in[5];
    float* mod = (float*)(F.ws + WS_MOD);
    LAS float* sc = F.sm;
    LAS float* red = F.sm + 5 * 1024;
    if (F.bid < 96) {
        for (int i = F.tid; i < 5 * 1024; i += NT) { const int r = i >> 10, k = i & 1023; const float x = r < 4 ? c[r * D + k] : cc[k]; sc[i] = x * sigmoid_acc(x); }
    }
    for (int u = F.bid; u < 96; u += F.G) {
        __syncthreads();
        const int col = u * 64 + F.lane, k0 = F.wave * 128;
        float a0 = 0.f, a1 = 0.f, a2 = 0.f, a3 = 0.f, a4 = 0.f;
#pragma unroll 16
        for (int k = 0; k < 128; ++k) { const float wv = w[(size_t)(k0 + k) * 6144 + col];
            a0 = fmaf(sc[k0 + k], wv, a0); a1 = fmaf(sc[1024 + k0 + k], wv, a1); a2 = fmaf(sc[2048 + k0 + k], wv, a2); a3 = fmaf(sc[3072 + k0 + k], wv, a3); a4 = fmaf(sc[4096 + k0 + k], wv, a4); }
        red[(F.wave * 5 + 0) * 64 + F.lane] = a0; red[(F.wave * 5 + 1) * 64 + F.lane] = a1; red[(F.wave * 5 + 2) * 64 + F.lane] = a2; red[(F.wave * 5 + 3) * 64 + F.lane] = a3; red[(F.wave * 5 + 4) * 64 + F.lane] = a4;
        __syncthreads();
        if (F.tid < 320) { const int r = F.tid >> 6, cl = F.tid & 63; float t = b[u * 64 + cl];
#pragma unroll
            for (int wv = 0; wv < 8; ++wv) t += red[(wv * 5 + r) * 64 + cl];
            mod[r * 6144 + u * 64 + cl] = t; }
    }
}
__device__ __forceinline__ void p_norm1(const Frame& F, bf16_t* dst) {
    const float* mod = (const float*)(F.ws + WS_MOD); const float* g = F.in[6];
    for (int row = F.bid * 8 + F.wave; row < NROW; row += F.G * 8) {
        const float* src; int r;
        if (row < NTOK) { src = F.in[0] + (size_t)row * D; r = row / SEQ; } else { src = F.in[2] + (size_t)(row - NTOK) * D; r = 4; }
        f4 v[4]; float ss = 0.f;
#pragma unroll
        for (int i = 0; i < 4; ++i) { v[i] = *(const f4*)(src + i * 256 + F.lane * 4); ss += v[i].x * v[i].x + v[i].y * v[i].y + v[i].z * v[i].z + v[i].w * v[i].w; }
        ss = wave_sum(ss);
        const float rs = rsqrtf(ss * (1.0f / D) + 1e-6f);
#pragma unroll
        for (int i = 0; i < 4; ++i) {
            const int cidx = i * 256 + F.lane * 4;
            const f4 gg = *(const f4*)(g + cidx), sh = *(const f4*)(mod + r * 6144 + cidx), sc = *(const f4*)(mod + r * 6144 + 1024 + cidx);
            u32x2 o; o.x = cvt_pk_bf16(v[i].x * rs * gg.x * (1.f + sc.x) + sh.x, v[i].y * rs * gg.y * (1.f + sc.y) + sh.y);
            o.y = cvt_pk_bf16(v[i].z * rs * gg.z * (1.f + sc.z) + sh.z, v[i].w * rs * gg.w * (1.f + sc.w) + sh.w);
            *(u32x2*)(dst + (size_t)row * D + cidx) = o;
        }
    }
}
__device__ __forceinline__ void p_cvt_lora(const Frame& F) {
    bf16_t* T = (bf16_t*)(F.ws + WS_LORAT);
    for (int idx = F.bid * NT + F.tid; idx < 2560 * 384; idx += F.G * NT) {
        const int n = idx / 384, kc = idx % 384, seg = n >> 9, ch = n & 511; float v = 0.f;
        if (seg < 2) { if ((kc >> 6) == seg) v = F.in[10][((size_t)seg * 64 + (kc & 63)) * RW + ch]; }
        else if (seg < 4) { if ((kc >> 6) == seg) v = F.in[12][((size_t)(seg - 2) * 64 + (kc & 63)) * RW + ch]; }
        else { if (kc >= 256) v = F.in[13][(size_t)(kc - 256) * RW + ch]; }
        T[idx] = f2bf(v);
    }
}
__device__ __forceinline__ void p_prepA(const Frame& F, const bf16_t* P, bf16_t* R, bf16_t* Kraw, bf16_t* V, bf16_t* A, bf16_t* Alora) {
    const float* mu = F.in[8]; const float* k_k = F.in[14];
    for (int row = F.bid * 8 + F.wave; row < NROW; row += F.G * 8) {
        const bf16_t* own = P + (size_t)row * PRW_LD;
        const bf16_t* nb[4]; bool ok[4];
        if (row < NTOK) { const int t = row % SEQ, gy = t >> 6, gx = t & 63;
            nb[0] = own - PRW_LD; ok[0] = gx > 0; nb[1] = own + PRW_LD; ok[1] = gx < 63; nb[2] = own - 64 * PRW_LD; ok[2] = gy > 0; nb[3] = own + 64 * PRW_LD; ok[3] = gy < 63;
        } else { const int t = (row - NTOK) % CTXL;
            nb[0] = own - PRW_LD; ok[0] = t > 0; nb[1] = own + PRW_LD; ok[1] = t < CTXL - 1; nb[2] = nb[0]; ok[2] = ok[0]; nb[3] = nb[1]; ok[3] = ok[1]; }
#pragma unroll
        for (int seg = 0; seg < 4; ++seg) {
            if (seg == 3 && F.lane >= 48) break;
            const int c0 = seg * 512 + F.lane * 8;
            const u32x4 pw = *(const u32x4*)(own + c0);
            u32x4 nw[4];
#pragma unroll
            for (int q = 0; q < 4; ++q) nw[q] = ok[q] ? *(const u32x4*)(nb[q] + c0) : (u32x4){0u, 0u, 0u, 0u};
            const f4 m0 = *(const f4*)(mu + c0), m1 = *(const f4*)(mu + c0 + 4);
            const float p[8] = {bf_lo(pw.x), bf_hi(pw.x), bf_lo(pw.y), bf_hi(pw.y), bf_lo(pw.z), bf_hi(pw.z), bf_lo(pw.w), bf_hi(pw.w)};
            const float sv[8] = {bf_lo(nw[0].x), bf_hi(nw[1].x), bf_lo(nw[2].y), bf_hi(nw[3].y), bf_lo(nw[0].z), bf_hi(nw[1].z), bf_lo(nw[2].w), bf_hi(nw[3].w)};
            const float mv[8] = {m0.x, m0.y, m0.z, m0.w, m1.x, m1.y, m1.z, m1.w};
            float o[8];
#pragma unroll
            for (int j = 0; j < 8; ++j) o[j] = p[j] + mv[j] * (sv[j] - p[j]);
            const size_t ro = (size_t)row * RW + F.lane * 8;
#define PK8(x_) (u32x4){cvt_pk_bf16(x_[0], x_[1]), cvt_pk_bf16(x_[2], x_[3]), cvt_pk_bf16(x_[4], x_[5]), cvt_pk_bf16(x_[6], x_[7])}
            if (seg == 0) { *(u32x4*)(R + ro) = PK8(o); }
            else if (seg == 2) { *(u32x4*)(V + ro) = PK8(o); }
            else if (seg == 1) {
                *(u32x4*)(Kraw + ro) = PK8(o);
                const f4 q0 = *(const f4*)(k_k + F.lane * 8), q1 = *(const f4*)(k_k + F.lane * 8 + 4);
                float x[8] = {o[0] * q0.x, o[1] * q0.y, o[2] * q0.z, o[3] * q0.w, o[4] * q1.x, o[5] * q1.y, o[6] * q1.z, o[7] * q1.w};
                float ss = 0.f;
#pragma unroll
                for (int j = 0; j < 8; ++j) ss += x[j] * x[j];
                const float rn = -rsqrtf(sum8(ss) + 1e-12f);
#pragma unroll
                for (int j = 0; j < 8; ++j) x[j] *= rn;
                *(u32x4*)(A + ro) = PK8(x);
            } else {
                if (F.lane < 16) {
#pragma unroll
                    for (int j = 0; j < 8; ++j) o[j] = tanhf(o[j]); }
                else if (F.lane >= 32) {
#pragma unroll
                    for (int j = 0; j < 8; ++j) o[j] = sigmoid_acc(o[j]); }
                u32x4 w; w.x = cvt_pk_bf16(o[0], o[1]); w.y = cvt_pk_bf16(o[2], o[3]); w.z = cvt_pk_bf16(o[4], o[5]); w.w = cvt_pk_bf16(o[6], o[7]);
                *(u32x4*)(Alora + (size_t)row * 384 + F.lane * 8) = w;
            }
        }
    }
}
constexpr int CQ_PITCH = 144, CQ_BYTES = 64 * CQ_PITCH, CQ_PER_WAVE = 24;
__device__ __forceinline__ void cq_decode(const Frame& F, int g, const float*& src, bf16_t*& dst) {
    const int m = g >> 8, e = m / 3, which = m - e * 3, kt = (g >> 4) & 15, nt = g & 15;
    src = (which == 0 ? F.in[29] : which == 1 ? F.in[31] : F.in[33]) + (size_t)e * D * D + (size_t)kt * 64 * D + nt * 64;
    dst = which == 2 ? (bf16_t*)F.out + ((size_t)e * 1024 + nt * 64) * 1024 + kt * 64
                     : (bf16_t*)(F.ws + WS_W1T) + ((size_t)e * 2048 + (nt >> 1) * 256 + (which == 1 ? 128 : 0) + (nt & 1) * 64) * 1024 + kt * 64;
}
__device__ __forceinline__ void cq_load(const Frame& F, int g, f4 (&cv)[16]) {
    const float* src; bf16_t* dst; cq_decode(F, g, src, dst);
    const int kb = F.lane >> 4, c4 = (F.lane & 15) * 4;
#pragma unroll
    for (int i = 0; i < 16; ++i) cv[i] = *(const f4*)(src + (size_t)(kb * 16 + i) * D + c4);
}
__device__ __forceinline__ void cq_write(const Frame& F, int g, const f4 (&cv)[16], LAS unsigned char* t) {
    const float* src; bf16_t* dst; cq_decode(F, g, src, dst);
    const int kb = F.lane >> 4, c4 = (F.lane & 15) * 4;
#pragma unroll
    for (int c = 0; c < 4; ++c) { u32x4 w0, w1;
        w0.x = cvt_pk_bf16(cv[0][c], cv[1][c]); w0.y = cvt_pk_bf16(cv[2][c], cv[3][c]); w0.z = cvt_pk_bf16(cv[4][c], cv[5][c]); w0.w = cvt_pk_bf16(cv[6][c], cv[7][c]);
        w1.x = cvt_pk_bf16(cv[8][c], cv[9][c]); w1.y = cvt_pk_bf16(cv[10][c], cv[11][c]); w1.z = cvt_pk_bf16(cv[12][c], cv[13][c]); w1.w = cvt_pk_bf16(cv[14][c], cv[15][c]);
        *(LAS u32x4*)(t + (c4 + c) * CQ_PITCH + kb * 32) = w0; *(LAS u32x4*)(t + (c4 + c) * CQ_PITCH + kb * 32 + 16) = w1; }
    __builtin_amdgcn_wave_barrier(); asm volatile("s_waitcnt lgkmcnt(0)" ::: "memory");
    const int k8 = F.lane & 7, n0 = F.lane >> 3;
#pragma unroll
    for (int j = 0; j < 8; ++j) { const int n = n0 + 8 * j; const u32x4 w = *(LAS u32x4*)(t + n * CQ_PITCH + k8 * 16); *(u32x4*)(dst + (size_t)n * 1024 + k8 * 8) = w; }
    __builtin_amdgcn_wave_barrier();
}
constexpr int SC_TB = 32, SC_STEPS = CTXL + SEQ, SC_NBLK = SC_STEPS / SC_TB;
constexpr int SC_BUF = 5 * SC_TB * 64 + SC_TB * 16 + SC_TB * 2;
__device__ __forceinline__ int scan_blk_row(int b, int dir, int blk) {
    const int p0 = blk * SC_TB;
    if (p0 < CTXL) return NTOK + b * CTXL + (dir ? (CTXL - 1 - p0) : p0);
    const int q = p0 - CTXL; return b * SEQ + (dir ? (SEQ - 1 - q) : q);
}
struct ScanRegs { u32x4 q[5]; u32x4 v; };
__device__ __forceinline__ void unpack8(const u32x4 w, float (&o)[8]) { o[0] = bf_lo(w.x); o[1] = bf_hi(w.x); o[2] = bf_lo(w.y); o[3] = bf_hi(w.y); o[4] = bf_lo(w.z); o[5] = bf_hi(w.z); o[6] = bf_lo(w.w); o[7] = bf_hi(w.w); }
template <int MODE> __device__ __forceinline__ void p_scan(const Frame& F, const bf16_t* R, const bf16_t* A, const bf16_t* V, const bf16_t* LW, const bf16_t* KD, const bf16_t* Bd, bf16_t* Y) {
    for (int u = F.bid; u < NB * NH * 2 * 4; u += F.G) {
        int vs, dir, h, b;
        if (F.G == 256) { vs = (u >> 3) & 3; const int ch = (u & 7) | ((u >> 5) << 3); dir = ch & 1; h = (ch >> 1) & 7; b = ch >> 4; }
        else { vs = u & 3; dir = (u >> 2) & 1; h = (u >> 3) & 7; b = u >> 6; }
        const size_t dofs = (size_t)dir * NROW * RW;
        const bf16_t* arr[5] = {R, LW + dofs, KD + dofs, A, Bd + dofs};
        bf16_t* Yd = Y + (size_t)dir * NTOK * RW;
        const bool comp = F.tid < 256;
        const int lt = F.tid & 255, sgn = dir ? -1 : 1;
        const int vl = lt >> 4, kq = lt & 15;
        const int l_st = lt >> 3, l_oct = lt & 7, l_off = sgn * l_st * RW + h * 64 + l_oct * 8, l_lds = l_st * 64 + l_oct * 8;
        const int v_st = (lt & 63) >> 1, v_hf = lt & 1, v_off = sgn * v_st * RW + h * 64 + vs * 16 + v_hf * 8;
        float S0 = 0.f, S1 = 0.f, S2 = 0.f, S3 = 0.f, yk = 0.f;
        ScanRegs qs[2];
        f4 cv[16];
        const bool do_cvt = (MODE == 0) && (F.G == 256) && (u == F.bid);
        LAS unsigned char* cq_t = F.lds + 2 * SC_BUF * 4 + ((F.wave - 4) & 3) * CQ_BYTES;
#define SC_LOAD(blk_, QS_) do { const size_t rb_ = (size_t)scan_blk_row(b, dir, (blk_)) * RW; _Pragma("unroll") for (int i = 0; i < 5; ++i) QS_.q[i] = *(const u32x4*)(arr[i] + rb_ + l_off); \
            if (lt < 64) QS_.v = *(const u32x4*)(V + rb_ + v_off); } while (0)
#define SC_ST8(buf_, off_, x_) do { *(LAS f4*)&(buf_)[(off_)] = (f4){x_[0], x_[1], x_[2], x_[3]}; *(LAS f4*)&(buf_)[(off_) + 4] = (f4){x_[4], x_[5], x_[6], x_[7]}; } while (0)
#define SC_STORE(buf_, QS_) do { float r_[8], w_[8], k_[8], a_[8], b_[8]; unpack8(QS_.q[0], r_); unpack8(QS_.q[1], w_); unpack8(QS_.q[2], k_); unpack8(QS_.q[3], a_); unpack8(QS_.q[4], b_); \
            float br_ = 0.f, kr_ = 0.f; _Pragma("unroll") for (int j = 0; j < 8; ++j) { w_[j] = __expf(w_[j]); br_ = fmaf(b_[j], r_[j], br_); kr_ = fmaf(k_[j], r_[j], kr_); r_[j] *= w_[j]; } \
            br_ = sum8(br_); kr_ = sum8(kr_); \
            SC_ST8(buf_, 0 * SC_TB * 64 + l_lds, r_); SC_ST8(buf_, 1 * SC_TB * 64 + l_lds, w_); SC_ST8(buf_, 2 * SC_TB * 64 + l_lds, k_); SC_ST8(buf_, 3 * SC_TB * 64 + l_lds, a_); SC_ST8(buf_, 4 * SC_TB * 64 + l_lds, b_); \
            if (l_oct == 0) { (buf_)[5 * SC_TB * 64 + SC_TB * 16 + l_st * 2] = br_; (buf_)[5 * SC_TB * 64 + SC_TB * 16 + l_st * 2 + 1] = kr_; } \
            if (lt < 64) { float v_[8]; unpack8(QS_.v, v_); SC_ST8(buf_, 5 * SC_TB * 64 + v_st * 16 + v_hf * 8, v_); } } while (0)
        __syncthreads();
        if (!comp) { SC_LOAD(0, qs[0]); SC_LOAD(1, qs[1]); SC_STORE(F.sm, qs[0]); SC_LOAD(2, qs[0]); }
        __syncthreads();
        for (int blk0 = 0; blk0 < SC_NBLK; blk0 += 2) {
#pragma unroll
          for (int j3 = 0; j3 < 2; ++j3) {
            const int blk = blk0 + j3;
            if (blk < SC_NBLK) {
            LAS float* cur = F.sm + (blk & 1) * SC_BUF;
            if (!comp) {
                LAS float* nb = F.sm + ((blk + 1) & 1) * SC_BUF;
                if (blk + 1 < SC_NBLK) SC_STORE(nb, qs[(j3 + 1) % 2]);
                if (blk + 3 < SC_NBLK) SC_LOAD(blk + 3, qs[(j3 + 1) % 2]);
                if (do_cvt) { const int jq = blk / 5, ph = blk - jq * 5;
                    if (jq < CQ_PER_WAVE) { const int g = jq * 1024 + F.bid * 4 + (F.wave - 4);
                        if (ph == 3) cq_write(F, g, cv, cq_t);
                        if (ph == 1) cq_load(F, g, cv); } }
            } else {
                const bool emit = blk * SC_TB >= CTXL;
                const int rowb = scan_blk_row(b, dir, blk);
                typedef float f2 __attribute__((ext_vector_type(2)));
#define SC_RD(st_, R01, R23, W01, W23, K01, K23, A01, A23, B01, B23, VV, BR, KR) do { \
                    const f4 r_ = *(LAS f4*)&cur[0 * SC_TB * 64 + (st_) * 64 + kq * 4], w_ = *(LAS f4*)&cur[1 * SC_TB * 64 + (st_) * 64 + kq * 4], k_ = *(LAS f4*)&cur[2 * SC_TB * 64 + (st_) * 64 + kq * 4], \
                             a_ = *(LAS f4*)&cur[3 * SC_TB * 64 + (st_) * 64 + kq * 4], b_ = *(LAS f4*)&cur[4 * SC_TB * 64 + (st_) * 64 + kq * 4]; \
                    R01 = (f2){r_.x, r_.y}; R23 = (f2){r_.z, r_.w}; W01 = (f2){w_.x, w_.y}; W23 = (f2){w_.z, w_.w}; K01 = (f2){k_.x, k_.y}; K23 = (f2){k_.z, k_.w}; \
                    A01 = (f2){a_.x, a_.y}; A23 = (f2){a_.z, a_.w}; B01 = (f2){b_.x, b_.y}; B23 = (f2){b_.z, b_.w}; VV = cur[5 * SC_TB * 64 + (st_) * 16 + vl]; \
                    const f2 sc_ = *(LAS f2*)&cur[5 * SC_TB * 64 + SC_TB * 16 + (st_) * 2]; BR = sc_.x; KR = sc_.y; } while (0)
                f2 S01 = (f2){S0, S1}, S23 = (f2){S2, S3};
                f2 nR01, nR23, nW01, nW23, nK01, nK23, nA01, nA23, nB01, nB23; float nV, nBR, nKR;
                SC_RD(0, nR01, nR23, nW01, nW23, nK01, nK23, nA01, nA23, nB01, nB23, nV, nBR, nKR);
#pragma unroll 1
                for (int half = 0; half < 2; ++half) {
#pragma unroll 4
                    for (int s16 = 0; s16 < 16; ++s16) {
                        const int st = half * 16 + s16;
                        const f2 R01 = nR01, R23 = nR23, W01 = nW01, W23 = nW23, K01 = nK01, K23 = nK23, A01 = nA01, A23 = nA23, B01 = nB01, B23 = nB23; const float vv = nV, brs = nBR, krs = nKR;
                        { const int sn = (st + 1) & (SC_TB - 1); SC_RD(sn, nR01, nR23, nW01, nW23, nK01, nK23, nA01, nA23, nB01, nB23, nV, nBR, nKR); }
                        const f2 sa2 = S01 * A01 + S23 * A23, yp2 = S01 * R01 + S23 * R23;
                        float sa = sa2.x + sa2.y, yp = yp2.x + yp2.y;
                        sa += dpp_f<0xB1>(sa); yp += dpp_f<0xB1>(yp); sa += dpp_f<0x4E>(sa); yp += dpp_f<0x4E>(yp);
                        sa += dpp_f<0x141>(sa); yp += dpp_f<0x141>(yp); sa += dpp_f<0x140>(sa); yp += dpp_f<0x140>(yp);
                        S01 = S01 * W01 + (B01 * sa + K01 * vv); S23 = S23 * W23 + (B23 * sa + K23 * vv);
                        const float y = fmaf(sa, brs, fmaf(vv, krs, yp));
                        yk = (kq == s16) ? y : yk;
                    }
                    if (emit) { const int row = rowb + sgn * (half * 16 + kq); Yd[(size_t)row * RW + h * 64 + vs * 16 + vl] = f2bf(yk); }
                }
                S0 = S01.x; S1 = S01.y; S2 = S23.x; S3 = S23.y;
#undef SC_RD
            }
            }
            __syncthreads();
          }
        }
#undef SC_LOAD
#undef SC_STORE
#undef SC_ST8
    }
}

typedef short bf16x4_t __attribute__((ext_vector_type(4)));
typedef float f32x4_t __attribute__((ext_vector_type(4)));
constexpr int CK_C = 16, CK_NCH = (CTXL + SEQ) / CK_C, CK_BYTES = 9472, CK_TASKS = NB * NH * 2 * CK_NCH;
constexpr size_t WS_FRAG = 288 * MiB;
static_assert(WS_FRAG + (size_t)CK_TASKS * CK_BYTES <= 512 * MiB, "fragment region");
static_assert(WS_FRAG + (size_t)CK_TASKS * CK_BYTES + 1024 <= WS_W1T + 16 * 4 * MiB, "W1t of experts >= 16 is written while the fragments are live");
__device__ __forceinline__ bf16x4_t pk4(const f32x4_t x) { u32x2 w; w.x = cvt_pk_bf16(x[0], x[1]); w.y = cvt_pk_bf16(x[2], x[3]); return __builtin_bit_cast(bf16x4_t, w); }
__device__ __forceinline__ bf16x8_t pk8(const f32x4_t lo, const f32x4_t hi) { u32x4 w; w.x = cvt_pk_bf16(lo[0], lo[1]); w.y = cvt_pk_bf16(lo[2], lo[3]); w.z = cvt_pk_bf16(hi[0], hi[1]); w.w = cvt_pk_bf16(hi[2], hi[3]); return __builtin_bit_cast(bf16x8_t, w); }
__device__ __forceinline__ bf16x8_t pk8a(const float* x) { u32x4 w; w.x = cvt_pk_bf16(x[0], x[1]); w.y = cvt_pk_bf16(x[2], x[3]); w.z = cvt_pk_bf16(x[4], x[5]); w.w = cvt_pk_bf16(x[6], x[7]); return __builtin_bit_cast(bf16x8_t, w); }
__device__ __forceinline__ f32x4_t mf32n_(bf16x8_t a, bf16x8_t b, f32x4_t c) { f32x4_t d = __builtin_amdgcn_mfma_f32_16x16x32_bf16(a, b, c, 0, 0, 0); asm volatile("s_nop 7" : "+v"(d)); return d; }
__device__ __forceinline__ f32x4_t mf16n_(bf16x4_t a, bf16x4_t b, f32x4_t c) { f32x4_t d = __builtin_amdgcn_mfma_f32_16x16x16bf16_1k(a, b, c, 0, 0, 0); asm volatile("s_nop 7" : "+v"(d)); return d; }
#define MF32N(a_, b_, c_) mf32n_((a_), (b_), (c_))
#define MF16N(a_, b_, c_) mf16n_((a_), (b_), (c_))
#define MF32(a_, b_, c_) __builtin_amdgcn_mfma_f32_16x16x32_bf16((a_), (b_), (c_), 0, 0, 0)
#define MF16(a_, b_, c_) __builtin_amdgcn_mfma_f32_16x16x16bf16_1k((a_), (b_), (c_), 0, 0, 0)
__device__ __forceinline__ int ck_row(int b, int dir, int p) {
    if (p < CTXL) return NTOK + b * CTXL + (dir ? (CTXL - 1 - p) : p);
    const int q = p - CTXL; return b * SEQ + (dir ? (SEQ - 1 - q) : q);
}
__device__ __forceinline__ void p_chunk_pre(const Frame& F, const bf16_t* R, const bf16_t* A, const bf16_t* LW, const bf16_t* KD, const bf16_t* Bd) {
    const int n = F.lane & 15, g = F.lane >> 4;
    const f32x4_t Z4 = {0.f, 0.f, 0.f, 0.f};
    bf16x8_t bid[2];
    { const int d = n - 4 * g;
#pragma unroll
      for (int hb = 0; hb < 2; ++hb) { u32x4 w = {0u, 0u, 0u, 0u}; if (d >= 0 && d < 4) { const int j = 4 * hb + d; const unsigned one = (j & 1) ? 0x3F800000u : 0x00003F80u; const int wi = j >> 1;
            w.x = wi == 0 ? one : 0u; w.y = wi == 1 ? one : 0u; w.z = wi == 2 ? one : 0u; w.w = wi == 3 ? one : 0u; } bid[hb] = __builtin_bit_cast(bf16x8_t, w); } }
    f32x4_t Idm, mLow, mUp, mUpE;
#pragma unroll
    for (int i = 0; i < 4; ++i) { const int row = 4 * g + i; Idm[i] = row == n ? 1.f : 0.f; mLow[i] = n < row ? 1.f : 0.f; mUp[i] = row < n ? 1.f : 0.f; mUpE[i] = row <= n ? 1.f : 0.f; }
    u32x4 nLW[2], nA[2], nB[2], nK[2], nR[2];
#define CK_IN(task_) do { const int ch_ = (task_) / CK_NCH, c_ = (task_) - ch_ * CK_NCH, dir_ = ch_ & 1; \
        const size_t ro_ = (size_t)ck_row(ch_ >> 4, dir_, c_ * CK_C + n) * RW + ((ch_ >> 1) & 7) * 64 + 16 * g, do_ = (size_t)dir_ * NROW * RW; \
        _Pragma("unroll") for (int t_ = 0; t_ < 2; ++t_) { nLW[t_] = *(const u32x4*)(LW + do_ + ro_ + 8 * t_); nA[t_] = *(const u32x4*)(A + ro_ + 8 * t_); nB[t_] = *(const u32x4*)(Bd + do_ + ro_ + 8 * t_); \
            nK[t_] = *(const u32x4*)(KD + do_ + ro_ + 8 * t_); nR[t_] = *(const u32x4*)(R + ro_ + 8 * t_); } } while (0)
    { const int t0 = F.bid * 8 + F.wave; if (t0 < CK_TASKS) CK_IN(t0); }
    for (int task = F.bid * 8 + F.wave; task < CK_TASKS; task += F.G * 8) {
        float at[16], rt[16], bh[16], kh[16], bc[16], kc[16], gam[16];
        {
            float lwv[16], Lc[16], av[16], bv[16], kv[16], rv[16];
#pragma unroll
            for (int t2 = 0; t2 < 2; ++t2) { unpack8(nLW[t2], *(float(*)[8])(lwv + 8 * t2)); unpack8(nA[t2], *(float(*)[8])(av + 8 * t2)); unpack8(nB[t2], *(float(*)[8])(bv + 8 * t2));
                unpack8(nK[t2], *(float(*)[8])(kv + 8 * t2)); unpack8(nR[t2], *(float(*)[8])(rv + 8 * t2)); }
            { const int tn = task + F.G * 8; if (tn < CK_TASKS) CK_IN(tn); }
#pragma unroll
            for (int e = 0; e < 16; ++e) { float x = lwv[e]; x += dpp_f<0x111>(x); x += dpp_f<0x112>(x); x += dpp_f<0x114>(x); x += dpp_f<0x118>(x); Lc[e] = x; gam[e] = __expf(sum16(lwv[e])); }
#pragma unroll
            for (int e = 0; e < 16; ++e) { const float eL = __expf(Lc[e]), ie = __builtin_amdgcn_rcpf(eL), eX = __expf(Lc[e] - lwv[e]);
                at[e] = av[e] * eX; rt[e] = rv[e] * eL; bh[e] = bv[e] * ie; kh[e] = kv[e] * ie; bc[e] = bh[e] * gam[e]; kc[e] = kh[e] * gam[e]; }
        }
        const bf16x8_t atF0 = pk8a(at), atF1 = pk8a(at + 8), rtF0 = pk8a(rt), rtF1 = pk8a(rt + 8), bhF0 = pk8a(bh), bhF1 = pk8a(bh + 8), khF0 = pk8a(kh), khF1 = pk8a(kh + 8);
        const bf16x8_t bcF0 = pk8a(bc), bcF1 = pk8a(bc + 8), kcF0 = pk8a(kc), kcF1 = pk8a(kc + 8);
        const f32x4_t Ld = MF32N(atF1, bhF1, MF32(atF0, bhF0, Z4)) * mLow;
        const f32x4_t LTd = MF32N(bhF1, atF1, MF32(bhF0, atF0, Z4)) * mUp;
        const f32x4_t Nd = MF32N(atF1, khF1, MF32(atF0, khF0, Z4)) * mLow;
        const f32x4_t QTd = MF32N(bhF1, rtF1, MF32(bhF0, rtF0, Z4)) * mUpE;
        const f32x4_t ZTd = MF32N(khF1, rtF1, MF32(khF0, rtF0, Z4)) * mUpE;
#define CK_PROD(xt_, y_) MF16N(pk4(xt_), pk4(y_), Z4)
        f32x4_t TT;
        { const f32x4_t P2 = CK_PROD(Ld, LTd), P2T = CK_PROD(LTd, Ld);
          const f32x4_t X1 = Idm + LTd, X1T = Idm + Ld;
          const f32x4_t X2 = X1 + CK_PROD(X1T, P2), X2T = X1T + CK_PROD(P2, X1T);
          const f32x4_t P4 = CK_PROD(P2T, P2), P4T = CK_PROD(P2, P2T);
          const f32x4_t X3 = X2 + CK_PROD(X2T, P4), X3T = X2T + CK_PROD(P4, X2T);
          const f32x4_t P8 = CK_PROD(P4T, P4);
          TT = X3 + CK_PROD(X3T, P8); }
        const bf16x4_t TTp = pk4(TT), QTp = pk4(QTd), Ndp = pk4(Nd);
        f32x4_t Mv = MF16(TTp, Ndp, Z4), MvT = MF16(Ndp, TTp, Z4);
        asm volatile("s_nop 7" : "+v"(Mv), "+v"(MvT));
        const bf16x4_t Mvp = pk4(Mv);
        unsigned char* outp = F.ws + WS_FRAG + (size_t)task * CK_BYTES;
        f32x4_t RpT[4], ApT[4];
#pragma unroll
        for (int tau = 0; tau < 4; ++tau) {
            f32x4_t atK = MF32(tau < 2 ? atF0 : atF1, bid[tau & 1], Z4);
            asm volatile("s_nop 7" : "+v"(atK));
            const bf16x4_t atKp = pk4(atK);
            f32x4_t Ap = MF16(TTp, atKp, Z4); ApT[tau] = MF16(atKp, TTp, Z4);
            asm volatile("s_nop 7" : "+v"(Ap), "+v"(ApT[tau]));
            const f32x4_t r0 = {rt[4 * tau], rt[4 * tau + 1], rt[4 * tau + 2], rt[4 * tau + 3]};
            RpT[tau] = MF16N(pk4(Ap), QTp, r0);
        }
        *(bf16x8_t*)(outp + 0 * 1024 + F.lane * 16) = pk8(RpT[0], RpT[1]);
        *(bf16x8_t*)(outp + 1 * 1024 + F.lane * 16) = pk8(RpT[2], RpT[3]);
        *(bf16x8_t*)(outp + 2 * 1024 + F.lane * 16) = pk8(ApT[0], ApT[1]);
        *(bf16x8_t*)(outp + 3 * 1024 + F.lane * 16) = pk8(ApT[2], ApT[3]);
        *(bf16x4_t*)(outp + 4096 + 0 * 512 + F.lane * 8) = pk4(MF16N(Mvp, QTp, ZTd));
        *(bf16x4_t*)(outp + 4096 + 1 * 512 + F.lane * 8) = pk4(MvT);
#pragma unroll
        for (int tp = 0; tp < 4; ++tp) {
            f32x4_t bcK = MF32(tp < 2 ? bcF0 : bcF1, bid[tp & 1], Z4), kcK = MF32(tp < 2 ? kcF0 : kcF1, bid[tp & 1], Z4);
            asm volatile("s_nop 7" : "+v"(bcK), "+v"(kcK));
            *(bf16x4_t*)(outp + 4096 + (2 + tp) * 512 + F.lane * 8) = pk4(bcK);
            *(bf16x4_t*)(outp + 4096 + (6 + tp) * 512 + F.lane * 8) = pk4(kcK);
        }
        if (n == 0) {
#pragma unroll
            for (int e4 = 0; e4 < 4; ++e4) *(f4*)(outp + 9216 + g * 64 + e4 * 16) = (f4){gam[4 * e4], gam[4 * e4 + 1], gam[4 * e4 + 2], gam[4 * e4 + 3]}; }
#undef CK_PROD
    }
#undef CK_IN
}
constexpr int CKR_SLOTS = 8, CKR_VOFF = 10240, CKR_SLOT = 12288, CKR_AHEAD = CKR_SLOTS - 1;
__device__ __forceinline__ void cs_tile(const Frame& F, int j, int ktb, int nt, const float*& src, bf16_t*& dst) {
    const int k0 = (ktb + 8 * (j & 1)) * 64, n0 = nt * 32;
    if (j < 64) { const int e = j >> 1; src = F.in[33] + (size_t)e * D * D + (size_t)k0 * D + n0; dst = (bf16_t*)F.out + ((size_t)e * 1024 + n0) * 1024 + k0; }
    else { const int jj = j - 64, e = 16 + (jj >> 2), up = (jj >> 1) & 1; src = (up ? F.in[31] : F.in[29]) + (size_t)e * D * D + (size_t)k0 * D + n0;
        dst = (bf16_t*)(F.ws + WS_W1T) + ((size_t)e * 2048 + (n0 >> 7) * 256 + up * 128 + (n0 & 127)) * 1024 + k0; }
}
__device__ __forceinline__ void cs_load(const Frame& F, int j, int ktb, int nt, int l8, int q, f4 (&cv)[8]) {
    const float* src; bf16_t* dst; cs_tile(F, j, ktb, nt, src, dst); src += (size_t)(l8 * 8) * D + q * 4;
#pragma unroll
    for (int i = 0; i < 8; ++i) cv[i] = *(const f4*)(src + (size_t)i * D);
}
__device__ __forceinline__ void cs_store(const Frame& F, int j, int ktb, int nt, int l8, int q, const f4 (&cv)[8]) {
    const float* src; bf16_t* dst; cs_tile(F, j, ktb, nt, src, dst); dst += (size_t)(q * 4) * 1024 + l8 * 8;
    u32x4 o;
    o.x = cvt_pk_bf16(cv[0].x, cv[1].x); o.y = cvt_pk_bf16(cv[2].x, cv[3].x); o.z = cvt_pk_bf16(cv[4].x, cv[5].x); o.w = cvt_pk_bf16(cv[6].x, cv[7].x); *(u32x4*)(dst) = o;
    o.x = cvt_pk_bf16(cv[0].y, cv[1].y); o.y = cvt_pk_bf16(cv[2].y, cv[3].y); o.z = cvt_pk_bf16(cv[4].y, cv[5].y); o.w = cvt_pk_bf16(cv[6].y, cv[7].y); *(u32x4*)(dst + 1024) = o;
    o.x = cvt_pk_bf16(cv[0].z, cv[1].z); o.y = cvt_pk_bf16(cv[2].z, cv[3].z); o.z = cvt_pk_bf16(cv[4].z, cv[5].z); o.w = cvt_pk_bf16(cv[6].z, cv[7].z); *(u32x4*)(dst + 2048) = o;
    o.x = cvt_pk_bf16(cv[0].w, cv[1].w); o.y = cvt_pk_bf16(cv[2].w, cv[3].w); o.z = cvt_pk_bf16(cv[4].w, cv[5].w); o.w = cvt_pk_bf16(cv[6].w, cv[7].w); *(u32x4*)(dst + 3072) = o;
}
__device__ __forceinline__ void p_chunk_scan(const Frame& F, const bf16_t* V, bf16_t* Y) {
    const int n = F.lane & 15, g = F.lane >> 4;
    const f32x4_t Z4 = {0.f, 0.f, 0.f, 0.f};
    constexpr int CKS_VS = 2, CKS_WG = 4 / CKS_VS;
    for (int u = F.bid; u < NB * NH * 2 * CKS_WG; u += F.G) {
        int chain, vpart;
        if (F.G == 256) { vpart = (u >> 3) % CKS_WG; chain = (u & 7) | ((u / (8 * CKS_WG)) << 3); } else { vpart = u % CKS_WG; chain = u / CKS_WG; }
        const int dir = chain & 1, h = (chain >> 1) & 7, b = chain >> 4;
        const unsigned char* fbase = F.ws + WS_FRAG + (size_t)chain * CK_NCH * CK_BYTES;
        __syncthreads();
        if (F.wave >= 4) {
            const int w = F.wave - 4;
#define CKR_DMA(c_) do { const unsigned char* p_ = fbase + (size_t)(c_) * CK_BYTES + F.lane * 16; LAS unsigned char* l_ = F.lds + ((c_) & (CKR_SLOTS - 1)) * CKR_SLOT; \
                _Pragma("unroll") for (int i_ = 0; i_ < 3; ++i_) { const int pc_ = i_ * 4 + w; \
                    if (pc_ < 10) __builtin_amdgcn_global_load_lds((const unsigned*)(p_ + pc_ * 1024), (LAS unsigned*)(l_ + pc_ * 1024), 16, 0, 0); \
                    else __builtin_amdgcn_global_load_lds((const unsigned*)(V + (size_t)ck_row(b, dir, (c_) * CK_C + (F.lane >> 3) + 8 * (pc_ - 10)) * RW + h * 64 + (F.lane & 7) * 8), (LAS unsigned*)(l_ + CKR_VOFF + (pc_ - 10) * 1024), 16, 0, 0); } } while (0)
#pragma unroll
            for (int c0 = 0; c0 < CKR_AHEAD; ++c0) CKR_DMA(c0);
            for (int c = 0; c < CK_NCH; ++c) {
                if (c + CKR_AHEAD - 1 < CK_NCH) asm volatile("s_waitcnt vmcnt(18)" ::: "memory"); else asm volatile("s_waitcnt vmcnt(0)" ::: "memory");
                __builtin_amdgcn_s_barrier();
                __builtin_amdgcn_s_barrier();
                if (c + CKR_AHEAD < CK_NCH) CKR_DMA(c + CKR_AHEAD);
            }
#undef CKR_DMA
        } else if (F.wave >= CKS_VS) {
            const int gq = u * 2 + (F.wave - CKS_VS), ktb = gq >> 5, nt = gq & 31, l8 = F.lane >> 3, q = F.lane & 7;
            f4 c0[8], c1[8];
            static_assert(CK_NCH % 8 == 0 && CK_NCH / 8 > CS_TILES / 2, "spare-wave schedule");
#define CS_BB __builtin_amdgcn_s_barrier(); __builtin_amdgcn_s_barrier();
            for (int m = 0; m < CK_NCH / 8; ++m) {
                const bool ld = m < CS_TILES / 2, st = m >= 1 && m <= CS_TILES / 2;
                CS_BB if (ld) cs_load(F, 2 * m, ktb, nt, l8, q, c0);
                CS_BB CS_BB
                CS_BB if (st) cs_store(F, 2 * m - 1, ktb, nt, l8, q, c1);
                CS_BB if (ld) cs_load(F, 2 * m + 1, ktb, nt, l8, q, c1);
                CS_BB CS_BB
                CS_BB if (ld) cs_store(F, 2 * m, ktb, nt, l8, q, c0);
            }
#undef CS_BB
        } else {
            const int vs = vpart * CKS_VS + (F.wave % CKS_VS); const bool act = true;
            bf16_t* Yd = Y + (size_t)dir * NTOK * RW;
            const size_t vcol = (size_t)h * 64 + vs * 16 + n;
            f32x4_t ST[4] = {Z4, Z4, Z4, Z4};
            for (int c = 0; c < CK_NCH; ++c) {
                const bf16x8_t bS0 = pk8(ST[0], ST[1]), bS1 = pk8(ST[2], ST[3]);
                __builtin_amdgcn_s_barrier();
                LAS unsigned char* sl = F.lds + (c & (CKR_SLOTS - 1)) * CKR_SLOT;
                bf16x8_t f16[4]; bf16x4_t f8[10]; f32x4_t gm[4]; unsigned vq[4];
                if (act) {
#pragma unroll
                for (int i = 0; i < 4; ++i) f16[i] = *(LAS bf16x8_t*)(sl + i * 1024 + F.lane * 16);
#pragma unroll
                for (int i = 0; i < 10; ++i) f8[i] = *(LAS bf16x4_t*)(sl + 4096 + i * 512 + F.lane * 8);
#pragma unroll
                for (int i = 0; i < 4; ++i) gm[i] = *(LAS f32x4_t*)(sl + 9216 + g * 64 + i * 16);
#pragma unroll
                for (int j = 0; j < 4; ++j) vq[j] = *(LAS bf16_t*)(sl + CKR_VOFF + (4 * g + j) * 128 + (vs * 16 + n) * 2);
                }
                asm volatile("s_waitcnt lgkmcnt(0)" ::: "memory");
                __builtin_amdgcn_s_barrier();
                if (act) {
                u32x2 vw; vw.x = vq[0] | (vq[1] << 16); vw.y = vq[2] | (vq[3] << 16); const bf16x4_t VF = __builtin_bit_cast(bf16x4_t, vw);
                f32x4_t tu = MF32(f16[3], bS1, MF32(f16[2], bS0, Z4)), ty = MF32(f16[1], bS1, MF32(f16[0], bS0, Z4));
                asm volatile("s_nop 7" : "+v"(tu), "+v"(ty));
                f32x4_t U = MF16(f8[1], VF, tu), Yc = MF16(f8[0], VF, ty);
#pragma unroll
                for (int tp = 0; tp < 4; ++tp) ST[tp] = MF16(f8[6 + tp], VF, ST[tp] * gm[tp]);
                asm volatile("s_nop 7" : "+v"(U), "+v"(Yc));
                const bf16x4_t Up = pk4(U);
#pragma unroll
                for (int tp = 0; tp < 4; ++tp) ST[tp] = MF16(f8[2 + tp], Up, ST[tp]);
                asm volatile("s_nop 7" : "+v"(ST[0]), "+v"(ST[1]), "+v"(ST[2]), "+v"(ST[3]));
                if (c >= CTXL / CK_C) {
#pragma unroll
                    for (int i = 0; i < 4; ++i) Yd[(size_t)ck_row(b, dir, c * CK_C + 4 * g + i) * RW + vcol] = f2bf(Yc[i]);
                }
                }
            }
        }
    }
}
__device__ __forceinline__ void p_readout(const Frame& F, const bf16_t* R, const bf16_t* KD, const bf16_t* V, const bf16_t* G, const bf16_t* Y, bf16_t* Ar) {
    const float* r_k = F.in[16]; const float* gn_w = F.in[17]; const float* gn_b = F.in[18];
    const int c0 = F.lane * 8;
    const f4 rk0 = *(const f4*)(r_k + c0), rk1 = *(const f4*)(r_k + c0 + 4), gw0 = *(const f4*)(gn_w + c0), gw1 = *(const f4*)(gn_w + c0 + 4), gb0 = *(const f4*)(gn_b + c0), gb1 = *(const f4*)(gn_b + c0 + 4);
    const float rk[8] = {rk0.x, rk0.y, rk0.z, rk0.w, rk1.x, rk1.y, rk1.z, rk1.w}, gw[8] = {gw0.x, gw0.y, gw0.z, gw0.w, gw1.x, gw1.y, gw1.z, gw1.w}, gb[8] = {gb0.x, gb0.y, gb0.z, gb0.w, gb1.x, gb1.y, gb1.z, gb1.w};
    for (int row = F.bid * 8 + F.wave; row < NTOK; row += F.G * 8) {
        const size_t o = (size_t)row * RW + c0;
        float y0[8], y1[8], r[8], k0[8], k1[8], v[8], g[8];
        unpack8(*(const u32x4*)(Y + o), y0); unpack8(*(const u32x4*)(Y + (size_t)NTOK * RW + o), y1); unpack8(*(const u32x4*)(R + o), r);
        unpack8(*(const u32x4*)(KD + o), k0); unpack8(*(const u32x4*)(KD + (size_t)NROW * RW + o), k1); unpack8(*(const u32x4*)(V + o), v); unpack8(*(const u32x4*)(G + o), g);
        float sy = 0.f, sb = 0.f;
#pragma unroll
        for (int j = 0; j < 8; ++j) { y0[j] += y1[j]; sy += y0[j]; sb = fmaf(r[j] * (k0[j] + k1[j]), rk[j], sb); }
        const float mu = sum8(sy) * (1.0f / 64.0f), bon = sum8(sb);
        float sq = 0.f;
#pragma unroll
        for (int j = 0; j < 8; ++j) { y0[j] -= mu; sq = fmaf(y0[j], y0[j], sq); }
        const float rs = rsqrtf(sum8(sq) * (1.0f / 64.0f) + 64e-5f);
        float oo[8];
#pragma unroll
        for (int j = 0; j < 8; ++j) oo[j] = (y0[j] * rs * gw[j] + gb[j] + bon * v[j]) * g[j];
        *(u32x4*)(Ar + o) = PK8(oo);
    }
}
__device__ __forceinline__ void moe_table(const Frame& F, LAS int* tb) {
    const unsigned* cnt = (const unsigned*)(F.ws + WS_CTL) + CW_CNT;
    __syncthreads();
    if (F.tid == 0) {
        int ts = 0;
        for (int e = 0; e < NE; ++e) { const int c = (int)cnt[e]; tb[e] = c; tb[32 + e] = ts; ts += (c + 255) / 256; }
        tb[64] = ts; tb[65] = ts;
    }
    __syncthreads();
}
__device__ __forceinline__ void p_final(const Frame& F, const bf16_t* x1, const bf16_t* ys) {
    const float* g = F.in[35]; const float* mod = (const float*)(F.ws + WS_MOD);
    const int lane = __builtin_amdgcn_mbcnt_hi(~0u, __builtin_amdgcn_mbcnt_lo(~0u, 0u));
    const int* pos = (const int*)(F.ws + WS_POS); const float* wgt = (const float*)(F.ws + WS_WGT);
    for (int row = F.bid * 8 + F.wave; row < NTOK; row += F.G * 8) {
        const bf16_t* src = x1 + (size_t)row * D; const int r = row / SEQ;
        const bf16_t* yr[4]; float wk[4];
#pragma unroll
        for (int k = 0; k < 4; ++k) { yr[k] = ys + (size_t)pos[row * 4 + k] * D; wk[k] = wgt[row * 4 + k]; }
        f4 v[4]; float ss = 0.f;
#pragma unroll
        for (int i = 0; i < 4; ++i) { const int cidx = i * 256 + lane * 4;
            f4 s = (f4){0.f, 0.f, 0.f, 0.f};
#pragma unroll
            for (int k = 0; k < 4; ++k) { const u32x2 y = *(const u32x2*)(yr[k] + cidx); s.x = fmaf(wk[k], bf_lo(y.x), s.x); s.y = fmaf(wk[k], bf_hi(y.x), s.y); s.z = fmaf(wk[k], bf_lo(y.y), s.z); s.w = fmaf(wk[k], bf_hi(y.y), s.w); }
            const f4 ga = *(const f4*)(mod + r * 6144 + 5120 + cidx);
            { const u32x2 xw = *(const u32x2*)(src + cidx); v[i] = (f4){bf_lo(xw.x), bf_hi(xw.x), bf_lo(xw.y), bf_hi(xw.y)} + ga * s; }
            ss += v[i].x * v[i].x + v[i].y * v[i].y + v[i].z * v[i].z + v[i].w * v[i].w; }
        ss = wave_sum(ss);
        const float rs = rsqrtf(ss * (1.0f / D) + 1e-6f);
#pragma unroll
        for (int i = 0; i < 4; ++i) { const int cidx = i * 256 + lane * 4; const f4 gg = *(const f4*)(g + cidx);
            f4 o; o.x = v[i].x * rs * gg.x; o.y = v[i].y * rs * gg.y; o.z = v[i].z * rs * gg.z; o.w = v[i].w * rs * gg.w;
            *(f4*)(F.out + (size_t)row * D + cidx) = o; }
    }
}

typedef float f32x16 __attribute__((ext_vector_type(16)));
__device__ __forceinline__ int crow32(int reg, int h) { return (reg & 3) + 8 * (reg >> 2) + 4 * h; }
__device__ __forceinline__ void split_hi_lo(const float (&u)[8], bf16x8_t& hi, bf16x8_t& lo) {
    u32x4 ph, pl;
#pragma unroll
    for (int j = 0; j < 4; ++j) { const unsigned w = cvt_pk_bf16(u[2 * j], u[2 * j + 1]); ph[j] = w;
        pl[j] = cvt_pk_bf16(u[2 * j] - bf_lo(w), u[2 * j + 1] - bf_hi(w)); }
    hi = __builtin_bit_cast(bf16x8_t, ph); lo = __builtin_bit_cast(bf16x8_t, pl);
}
__device__ __forceinline__ void p_cvt_router(const Frame& F) {
    const float* rw = F.in[27]; bf16_t* hi = (bf16_t*)(F.ws + WS_WRT); bf16_t* lo = hi + 32 * 1024;
    for (int idx = F.bid * NT + F.tid; idx < 32 * 1024; idx += F.G * NT) { const int e = idx >> 10, k = idx & 1023; const float v = rw[k * NE + e];
        const unsigned w = cvt_pk_bf16(v, 0.f); hi[idx] = (bf16_t)(w & 0xffffu); lo[idx] = f2bf(v - bf_lo(w)); }
}
__device__ __forceinline__ void p_router_consts(const Frame& F) {
    const float* mod = (const float*)(F.ws + WS_MOD); const float* g = F.in[26];
    float* gs2 = (float*)(F.ws + WS_GS2);
    if (F.bid == F.G - 1) { for (int i = F.tid; i < 4 * 1024; i += NT) { const int b = i >> 10, k = i & 1023; gs2[i] = g[k] * (1.0f + mod[b * 6144 + 4096 + k]); } }
}
__device__ __forceinline__ void p_router2(const Frame& F, const bf16_t* x1, bf16_t* h2) {
    const float* mod = (const float*)(F.ws + WS_MOD); const float* ssp = (const float*)(F.ws + WS_SSP); const float* rb = F.in[28];
    const bf16_t* whi = (const bf16_t*)(F.ws + WS_WRT); const bf16_t* wlo = whi + 32 * 1024;
    const float* gs2 = (const float*)(F.ws + WS_GS2);
    unsigned* cnt = (unsigned*)(F.ws + WS_CTL) + CW_CNT; int* lst = (int*)(F.ws + WS_LIST); float* wgt = (float*)(F.ws + WS_WGT);
    const int tl = F.wave >> 2, kp = F.wave & 3, r = F.lane & 31, h = F.lane >> 5;
    LAS float* part = F.sm + (tl * 4 + kp) * 1024;
    LAS float* lg = F.sm + 8192 + 1024 + tl * (32 * 33);
    for (int t0 = F.bid * 2; t0 < NTOK / 32; t0 += F.G * 2) {
        const int row0 = (t0 + tl) * 32, b = row0 / SEQ;
        const bf16_t* xr = x1 + (size_t)(row0 + r) * D + kp * 256 + 8 * h;
        bf16_t* hr = h2 + (size_t)(row0 + r) * D + kp * 256 + 8 * h;
        const float* gp = gs2 + b * 1024 + kp * 256 + 8 * h; const float* sp = mod + b * 6144 + 3072 + kp * 256 + 8 * h;
        const bf16_t* wh = whi + r * 1024 + kp * 256 + 8 * h; const bf16_t* wl = wlo + r * 1024 + kp * 256 + 8 * h;
        float rstd;
        { const f4* q = (const f4*)(ssp + (size_t)(row0 + r) * 16); const f4 q0 = q[0], q1 = q[1], q2 = q[2], q3 = q[3];
          const float tot = (((q0.x + q0.y) + (q0.z + q0.w)) + ((q1.x + q1.y) + (q1.z + q1.w))) + (((q2.x + q2.y) + (q2.z + q2.w)) + ((q3.x + q3.y) + (q3.z + q3.w)));
          rstd = rsqrtf(tot * (1.0f / D) + 1e-6f); }
        f32x16 acc;
#pragma unroll
        for (int i = 0; i < 16; ++i) acc[i] = 0.f;
#pragma unroll 4
        for (int ks = 0; ks < 16; ++ks) {
            const u32x4 xw = *(const u32x4*)(xr + ks * 16); const f4 g0 = *(const f4*)(gp + ks * 16), g1 = *(const f4*)(gp + ks * 16 + 4);
            const f4 s0 = *(const f4*)(sp + ks * 16), s1 = *(const f4*)(sp + ks * 16 + 4);
            const bf16x8_t bh = *(const bf16x8_t*)(wh + ks * 16), bl = *(const bf16x8_t*)(wl + ks * 16);
            const float u[8] = {bf_lo(xw.x) * rstd * g0.x + s0.x, bf_hi(xw.x) * rstd * g0.y + s0.y, bf_lo(xw.y) * rstd * g0.z + s0.z, bf_hi(xw.y) * rstd * g0.w + s0.w,
                                bf_lo(xw.z) * rstd * g1.x + s1.x, bf_hi(xw.z) * rstd * g1.y + s1.y, bf_lo(xw.w) * rstd * g1.z + s1.z, bf_hi(xw.w) * rstd * g1.w + s1.w};
            bf16x8_t ah, al; split_hi_lo(u, ah, al);
            *(bf16x8_t*)(hr + ks * 16) = ah;
            acc = __builtin_amdgcn_mfma_f32_32x32x16_bf16(ah, bh, acc, 0, 0, 0);
            acc = __builtin_amdgcn_mfma_f32_32x32x16_bf16(al, bh, acc, 0, 0, 0);
            acc = __builtin_amdgcn_mfma_f32_32x32x16_bf16(ah, bl, acc, 0, 0, 0);
        }
        asm volatile("s_nop 15\n\ts_nop 7" : "+v"(acc));
        __syncthreads();
#pragma unroll
        for (int i = 0; i < 16; ++i) part[i * 64 + F.lane] = acc[i];
        __syncthreads();
        if (kp == 0) {
            LAS float* p0 = F.sm + (tl * 4) * 1024;
            const float bb = rb[r];
#pragma unroll
            for (int i = 0; i < 16; ++i) { const float a = (p0[i * 64 + F.lane] + p0[1024 + i * 64 + F.lane]) + (p0[2048 + i * 64 + F.lane] + p0[3072 + i * 64 + F.lane]);
                const int rw_ = crow32(i, h); lg[rw_ * 33 + r] = a + bb; }
            __builtin_amdgcn_wave_barrier(); asm volatile("s_waitcnt lgkmcnt(0)" ::: "memory");
            if (F.lane < 32) {
                float tv[4]; int te[4]; unsigned used = 0u;
#pragma unroll
                for (int k = 0; k < 4; ++k) { float best = -3.0e38f; int bi = 0;
#pragma unroll
                    for (int e = 0; e < 32; ++e) { const float x = lg[F.lane * 33 + e]; if (!((used >> e) & 1u) && x > best) { best = x; bi = e; } }
                    used |= 1u << bi; tv[k] = best; te[k] = bi; }
                float ex[4], sum = 0.f;
#pragma unroll
                for (int k = 0; k < 4; ++k) { ex[k] = expf(tv[k] - tv[0]); sum += ex[k]; }
                const int row = row0 + F.lane;
#pragma unroll
                for (int k = 0; k < 4; ++k) { const unsigned pos = atomicAdd(&cnt[te[k]], 1u); lst[(size_t)te[k] * ECAP + pos] = row * 4 + k; wgt[row * 4 + k] = ex[k] / sum; }
            }
        }
    }
}
constexpr int SG_PITCH = 272;
__device__ __forceinline__ void p_sgu2(const Frame& F, const bf16_t* Gs, bf16_t* As_, int u0, int ustride) {
    const float* lnw = F.in[20]; const float* lnb = F.in[21]; const float* Wsp = F.in[22]; const float* bsp = F.in[23];
    LAS unsigned char* zt = F.lds;
    const int r = F.lane & 31, h = F.lane >> 5;
    for (int u = u0; u < NB * 32 * 2; u += ustride) {
        const int gh = u & 1, n = (u >> 1) & 31, b = u >> 6;
        const int row0 = b * SEQ + n * 128;
        __syncthreads();
        for (int p = F.wave; p < 128; p += 8) {
            const u32x4 zw = *(const u32x4*)(Gs + (size_t)(row0 + p) * 1024 + 512 + F.lane * 8);
            float z[8] = {bf_lo(zw.x), bf_hi(zw.x), bf_lo(zw.y), bf_hi(zw.y), bf_lo(zw.z), bf_hi(zw.z), bf_lo(zw.w), bf_hi(zw.w)};
            float sm_ = 0.f;
#pragma unroll
            for (int j = 0; j < 8; ++j) sm_ += z[j];
            const float mu = wave_sum(sm_) * (1.0f / 512.0f);
            float q = 0.f;
#pragma unroll
            for (int j = 0; j < 8; ++j) { const float d = z[j] - mu; q += d * d; }
            const float rs = rsqrtf(wave_sum(q) * (1.0f / 512.0f) + 1e-5f);
            if ((F.lane >> 5) == gh) { const int cl = (F.lane & 31) * 8, ch = F.lane * 8;
#pragma unroll
                for (int j = 0; j < 8; ++j) *(LAS bf16_t*)(zt + (cl + j) * SG_PITCH + p * 2) = f2bf((z[j] - mu) * rs * lnw[ch + j] + lnb[ch + j]); }
        }
        __syncthreads();
        const int ct = F.wave & 1, pt = F.wave >> 1;
#pragma unroll 1
        for (int gl = 0; gl < 4; ++gl) {
            const int g = gh * 4 + gl;
            f32x16 acc;
#pragma unroll
            for (int i = 0; i < 16; ++i) acc[i] = 0.f;
            const float* wp = Wsp + ((size_t)g * 128 + pt * 32 + r) * 128 + 8 * h;
            LAS unsigned char* ap = zt + (gl * 64 + ct * 32 + r) * SG_PITCH + 16 * h;
#pragma unroll
            for (int ks = 0; ks < 8; ++ks) {
                const bf16x8_t a = *(LAS bf16x8_t*)(ap + ks * 32);
                const f4 w0 = *(const f4*)(wp + ks * 16), w1 = *(const f4*)(wp + ks * 16 + 4);
                u32x4 bw; bw.x = cvt_pk_bf16(w0.x, w0.y); bw.y = cvt_pk_bf16(w0.z, w0.w); bw.z = cvt_pk_bf16(w1.x, w1.y); bw.w = cvt_pk_bf16(w1.z, w1.w);
                acc = __builtin_amdgcn_mfma_f32_32x32x16_bf16(a, __builtin_bit_cast(bf16x8_t, bw), acc, 0, 0, 0);
            }
            asm volatile("s_nop 15\n\ts_nop 7" : "+v"(acc));
            const int p = pt * 32 + r, row = row0 + p; const float bias = bsp[g * 128 + p];
#pragma unroll
            for (int q4 = 0; q4 < 4; ++q4) { const int c = ct * 32 + 8 * q4 + 4 * h;
                const u32x2 uw = *(const u32x2*)(Gs + (size_t)row * 1024 + g * 64 + c);
                u32x2 o; o.x = cvt_pk_bf16(bf_lo(uw.x) * (acc[q4 * 4 + 0] + bias), bf_hi(uw.x) * (acc[q4 * 4 + 1] + bias));
                o.y = cvt_pk_bf16(bf_lo(uw.y) * (acc[q4 * 4 + 2] + bias), bf_hi(uw.y) * (acc[q4 * 4 + 3] + bias));
                *(u32x2*)(As_ + (size_t)row * RW + g * 64 + c) = o; }
        }
    }
}

constexpr int LDS_BYTES = mg::STAGE_BYTES + 16384;
constexpr int N_PHASES = 16;

__global__ void __launch_bounds__(NT, 2) fwd_kernel(Args args) {
    extern __shared__ __attribute__((aligned(16))) unsigned char lds_raw[];
    Frame F;
    F.in = args.in; F.out = args.out; F.ws = args.ws;
    F.sm = (LAS float*)lds_raw; F.lds = (LAS unsigned char*)lds_raw;
    F.tid = threadIdx.x; F.lane = F.tid & 63; F.wave = __builtin_amdgcn_readfirstlane(F.tid >> 6); F.G = gridDim.x; F.bid = blockIdx.x;
    volatile LAS unsigned* xbw = (volatile LAS unsigned*)(lds_raw + LDS_BYTES - 16);
    LAS int* tb = (LAS int*)(lds_raw + mg::STAGE_BYTES);
    if (F.tid == 0) { xbw[0] = 0u; xbw[1] = 0u; xbw[2] = 0u; xbw[3] = 0u; }
    __syncthreads();
    XcdBarrier bar = xcd_barrier_post((unsigned*)(F.ws + WS_CTL), xbw);
    const int lo = args.ph_lo, hi = args.ph_hi;
#ifndef PH_MASK
#define PH_MASK 0xFFFFFFFFu
#endif
#define IN(k) (((PH_MASK >> (k)) & 1u) && lo <= (k) && (k) < hi)
#define SEAM(k) do { if (IN(k) && IN((k) + 1)) xcd_barrier(bar); } while (0)
    unsigned char* ws = F.ws;
    float* mod = (float*)(ws + WS_MOD);
    bf16_t* Hb = (bf16_t*)(ws + WS_H); bf16_t* Prw = (bf16_t*)(ws + WS_PRW); bf16_t* GateA = (bf16_t*)(ws + WS_GA); bf16_t* Gsgu = (bf16_t*)(ws + WS_GSGU); bf16_t* GateB = (bf16_t*)(ws + WS_GB);
    bf16_t* Asg = (bf16_t*)(ws + WS_AS); bf16_t* Mb = (bf16_t*)(ws + WS_M);
    bf16_t* Rr = (bf16_t*)(ws + WS_R); bf16_t* LW = (bf16_t*)(ws + WS_LW); bf16_t* Kraw = (bf16_t*)(ws + WS_KRAW); bf16_t* Alora = (bf16_t*)(ws + WS_ALORA);
    bf16_t* Aa = (bf16_t*)(ws + WS_A); bf16_t* Vv = (bf16_t*)(ws + WS_V); bf16_t* KD = (bf16_t*)(ws + WS_KD); bf16_t* Bd = (bf16_t*)(ws + WS_B); bf16_t* Gg = (bf16_t*)(ws + WS_G);
    bf16_t* Yd = (bf16_t*)(ws + WS_YD); bf16_t* Arb = (bf16_t*)(ws + WS_AR);
    bf16_t* X1 = (bf16_t*)(ws + WS_X1); bf16_t* H2 = (bf16_t*)(ws + WS_H2); bf16_t* Act = (bf16_t*)(ws + WS_ACT);
    bf16_t* W1t = (bf16_t*)(ws + WS_W1T); bf16_t* W2t = (bf16_t*)F.out; bf16_t* Ys = (bf16_t*)(ws + 292 * MiB);
    const int* lst = (const int*)(ws + WS_LIST); const float* wgt = (const float*)(ws + WS_WGT);

    if (IN(0)) { p_mod(F); p_cvt_small(F); p_cvt_router(F); p_cvt_lora(F); }
    SEAM(0);
    if (IN(1)) { p_router_consts(F); p_norm1(F, Hb); }
    SEAM(1);
    if (IN(2)) { mg::PProb P{Hb, (const bf16_t*)(ws + WS_WINT), F.G, F.bid}; mg::EpiP E{Prw, Gsgu, GateA}; mg::gemm_run(F.lds, P, E); }
    SEAM(2);
    if (IN(5)) p_prepA(F, Prw, Rr, Kraw, Vv, Aa, Alora);
    SEAM(5);
    if (IN(6)) { mg::LoraProb P{Alora, (const bf16_t*)(ws + WS_LORAT), F.G, F.bid}; mg::EpiLora E{LW, KD, Bd, Gg, Kraw, Aa, F.in[9], F.in[11], F.in[15]}; mg::gemm_run(F.lds, P, E); }
    SEAM(6);
#ifdef USE_SEQ_SCAN
    if (IN(7)) p_scan<0>(F, Rr, Aa, Vv, LW, KD, Bd, Yd);
#else
    if (IN(7)) { p_chunk_pre(F, Rr, Aa, LW, KD, Bd); xcd_barrier(bar);
        if (F.G >= 256) { if (F.bid < 128) p_chunk_scan(F, Vv, Yd);
            else { p_sgu2(F, Gsgu, Asg, F.bid - 128, F.G - 128);
                   mg::DenseProb P{Hb, (const bf16_t*)(ws + WS_WINT) + (size_t)4096 * 1024, 64, 4, 1024, F.G - 128, F.bid - 128}; mg::EpiSig E{GateB}; mg::gemm_run(F.lds, P, E); } }
        else { p_chunk_scan(F, Vv, Yd); p_sgu2(F, Gsgu, Asg, F.bid, F.G);
               mg::DenseProb P{Hb, (const bf16_t*)(ws + WS_WINT) + (size_t)4096 * 1024, 64, 4, 1024, F.G, F.bid}; mg::EpiSig E{GateB}; mg::gemm_run(F.lds, P, E); } }
#endif
    SEAM(7);
    if (IN(8)) p_readout(F, Rr, KD, Vv, Gg, Yd, Arb);
    SEAM(8);
    if (IN(9)) { if (F.G == 256) { mg::YYProb P{Asg, Arb, (const bf16_t*)(ws + WS_WOS), (const bf16_t*)(ws + WS_WOR), F.G, F.bid}; mg::EpiYY E{Mb, GateA, GateB}; mg::gemm_run(F.lds, P, E); }
        else {
        { mg::DenseProb P{Asg, (const bf16_t*)(ws + WS_WOS), 64, 4, 512, F.G, F.bid}; mg::EpiGateMul<false> E{Mb, GateB}; mg::gemm_run(F.lds, P, E); }
        { mg::DenseProb P{Arb, (const bf16_t*)(ws + WS_WOR), 64, 4, 512, F.G, F.bid}; mg::EpiGateMul<true> E{Mb, GateA}; mg::gemm_run(F.lds, P, E); } } }
    SEAM(9);
    if (IN(10)) { mg::DenseProb P{Mb, (const bf16_t*)(ws + WS_WOT), 64, 4, 1024, F.G, F.bid}; mg::EpiX1 E{X1, F.in[0], mod, (float*)(ws + WS_SSP)}; mg::gemm_run(F.lds, P, E); }
    SEAM(10);
#ifdef USE_SEQ_SCAN
    if (IN(11)) { p_router2(F, X1, H2); if (F.G != 256) p_cvt_experts(F); }
#else
    if (IN(11)) { p_router2(F, X1, H2); p_cvt_experts(F); }
#endif
    SEAM(11);
    int moe_r1 = 0, moe_fill = 0, moe_rank = -1; bool moe_has_last = false;
    if (IN(12)) { moe_table(F, tb); LAS int* rtab = (LAS int*)(lds_raw + mg::STAGE_BYTES + 1024);
        const int RT = tb[65], S1 = (RT + 3) >> 2; moe_r1 = F.G == 256 ? (S1 + 7) >> 3 : 0;
        if (F.G == 256 && moe_r1 >= 2) {
            int nidle = 0, rank = -1;
            for (int cc = 0; cc < 256; ++cc) { const bool has = 4 * ((moe_r1 - 1) * 8 + (cc & 7)) + ((cc >> 3) & 3) < RT; if (cc == F.bid) { moe_has_last = has; rank = nidle; } if (!has) ++nidle; }
            moe_fill = nidle >> 5;
            if (moe_fill * 8 > (moe_r1 - 1) * 32) moe_fill = ((moe_r1 - 1) * 32) >> 3;
            if (moe_fill * 8 > RT) moe_fill = RT >> 3;
            moe_rank = (!moe_has_last && rank < moe_fill * 32) ? rank : -1;
            mg::Moe1Prob P{H2, W1t, lst, tb, rtab, F.G, F.bid, 0, moe_r1 - 1}; P.fill(rtab, (int*)(ws + WS_POS)); mg::EpiMoe1 E{Act, F.in[30], F.in[32]}; mg::gemm_run(F.lds, P, E);
        } else { moe_r1 = 0; mg::Moe1Prob P{H2, W1t, lst, tb, rtab, F.G, F.bid, 0, 1 << 20}; P.fill(rtab, (int*)(ws + WS_POS)); mg::EpiMoe1 E{Act, F.in[30], F.in[32]}; mg::gemm_run(F.lds, P, E); }
    }
    SEAM(12);
    if (IN(13)) { LAS int* rtab = (LAS int*)(lds_raw + mg::STAGE_BYTES + 1024);
        if (moe_r1 >= 2) {
            if (moe_has_last) { mg::Moe1Prob P{H2, W1t, lst, tb, rtab, F.G, F.bid, moe_r1 - 1, moe_r1}; P.fill(rtab, (int*)(ws + WS_POS)); mg::EpiMoe1 E{Act, F.in[30], F.in[32]}; mg::gemm_run(F.lds, P, E); }
            else if (moe_rank >= 0) { mg::Moe2Prob P{Act, W2t, tb, F.G, F.bid, 0, moe_rank}; mg::EpiMoe2 E{Ys, F.in[34]}; mg::gemm_run(F.lds, P, E); }
            xcd_barrier(bar);
        }
        { mg::Moe2Prob P{Act, W2t, tb, F.G, F.bid, moe_fill, -1}; mg::EpiMoe2 E{Ys, F.in[34]}; mg::gemm_run(F.lds, P, E); }
    }
    SEAM(13);
    if (IN(14)) p_final(F, X1, Ys);
#undef IN
#undef SEAM
}

extern "C" void kernel_launch(void* const* d_in, const int* in_sizes, int n_in, void* d_out, int out_size, void* d_ws, size_t ws_size, hipStream_t stream) {
    static int grid = 0;
    if (grid == 0) {
        if (n_in != 36 || out_size != NTOK * D || ws_size < WS_END) { fprintf(stderr, "kernel_launch: unexpected shapes (n_in %d out %d ws %zu, need %zu)\n", n_in, out_size, ws_size, (size_t)WS_END); grid = -1; return; }
        int dev = 0, cus = 0, per_cu = 0;
        if (hipGetDevice(&dev) != hipSuccess || hipDeviceGetAttribute(&cus, hipDeviceAttributeMultiprocessorCount, dev) != hipSuccess) { grid = -1; return; }
        if (hipFuncSetAttribute((const void*)fwd_kernel, hipFuncAttributeMaxDynamicSharedMemorySize, LDS_BYTES) != hipSuccess) { grid = -1; return; }
        if (hipOccupancyMaxActiveBlocksPerMultiprocessor(&per_cu, (const void*)fwd_kernel, NT, LDS_BYTES) != hipSuccess || per_cu < 1) { fprintf(stderr, "occupancy query: %d\n", per_cu); }
        (void)hipGetLastError();
        grid = cus;
    }
    if (grid < 0) return;
    (void)hipMemsetAsync((char*)d_ws + WS_CTL, 0, CTL_BYTES + 131072, stream);
    Args a{};
    for (int i = 0; i < 36; ++i) a.in[i] = (const float*)d_in[i];
    a.out = (float*)d_out; a.ws = (unsigned char*)d_ws; a.ph_lo = 0; a.ph_hi = N_PHASES;
    hipLaunchKernelGGL(fwd_kernel, dim3(grid), dim3(NT), LDS_BYTES, stream, a);
}
```

```cpp
#include <hip/hip_runtime.h>
#include <cstdio>
#include <cstdint>

#define XB_TMO      128
#define XB_XCNT(j)  (256  + 64 * (j))
#define XB_XSUB(j)  (1280 + 64 * (j))
#define XB_XGEN(j)  (2304 + 64 * (j))
#define XB_TOP      3328
#define XB_TOPGEN   3392
#define XCD_BAR_WORDS 3456
#define XB_SPIN_CAP (1u << 21)
#define LAS __attribute__((address_space(3)))

__device__ __forceinline__ unsigned xb_ld(unsigned* p)              { return __hip_atomic_load(p, __ATOMIC_RELAXED, __HIP_MEMORY_SCOPE_AGENT); }
__device__ __forceinline__ unsigned xb_add(unsigned* p, unsigned v) { return __hip_atomic_fetch_add(p, v, __ATOMIC_RELAXED, __HIP_MEMORY_SCOPE_AGENT); }
__device__ __forceinline__ unsigned xb_xcc_id() { return (unsigned)__builtin_amdgcn_s_getreg((3 << 11) | 20) & 0xFu; }
#define XB_SPIN(cond, bar) do { unsigned _sp = 0; while (cond) { __builtin_amdgcn_s_sleep(1); \
    if ((++_sp & 255u) == 0u) { if (xb_ld(&(bar)[XB_TMO])) break; if (_sp > XB_SPIN_CAP) { atomicAdd(&(bar)[XB_TMO], 1u); break; } } } } while (0)

struct XcdBarrier {
    unsigned* bar; unsigned x;
    volatile LAS unsigned* st;
};

__device__ __forceinline__ XcdBarrier xcd_barrier_post(unsigned* bar, volatile LAS unsigned* st, unsigned& rank) {
    XcdBarrier b; b.bar = bar; b.x = xb_xcc_id(); b.st = st; rank = 0u;
    if (threadIdx.x == 0) rank = xb_add(&bar[XB_XCNT(b.x)], 1u);
    return b;
}
__device__ __forceinline__ void xcd_barrier_complete(unsigned* bar, unsigned x, unsigned& nloc, unsigned& nx) {
    const unsigned G = gridDim.x * gridDim.y * gridDim.z;
    unsigned sum, cnt, mine, sp = 0u;
    for (;;) {
        sum = 0u; cnt = 0u; mine = 0u;
#pragma unroll
        for (unsigned j = 0; j < 16; ++j) { const unsigned c = xb_ld(&bar[XB_XCNT(j)]); sum += c; cnt += (c > 0u) ? 1u : 0u; mine = (j == x) ? c : mine; }
        if (sum == G) break;
        __builtin_amdgcn_s_sleep(1);
        if ((++sp & 255u) == 0u) { if (xb_ld(&bar[XB_TMO])) break; if (sp > XB_SPIN_CAP) { atomicAdd(&bar[XB_TMO], 1u); break; } }
    }
    nloc = mine > 0u ? mine : 1u; nx = cnt > 0u ? cnt : 1u;
}

__device__ __forceinline__ void xcd_barrier(const XcdBarrier& b) {
    asm volatile("s_waitcnt vmcnt(0)" ::: "memory");
    __syncthreads();
    if (threadIdx.x == 0) {
        unsigned* bar = b.bar;
        __builtin_amdgcn_s_waitcnt(0);
        unsigned nloc = b.st[0], nx = b.st[1];
        if (nloc == 0u) { xcd_barrier_complete(bar, b.x, nloc, nx); b.st[0] = nloc; b.st[1] = nx; }
        const unsigned old = xb_add(&bar[XB_XSUB(b.x)], 1u);
        const unsigned gen = old / nloc;
        if (old + 1u == (gen + 1u) * nloc) {
            __builtin_amdgcn_fence(__ATOMIC_RELEASE, "agent");
            asm volatile("s_waitcnt vmcnt(0)" ::: "memory");
            const unsigned og = xb_add(&bar[XB_TOP], 1u);
            const unsigned tg = og / nx;
            if (og + 1u == (tg + 1u) * nx) xb_add(&bar[XB_TOPGEN], 1u);
            else XB_SPIN(xb_ld(&bar[XB_TOPGEN]) == tg, bar);
            __builtin_amdgcn_fence(__ATOMIC_ACQUIRE, "agent");
            xb_add(&bar[XB_XGEN(b.x)], 1u);
            asm volatile("s_waitcnt vmcnt(0)" ::: "memory");
        } else {
            XB_SPIN(xb_ld(&bar[XB_XGEN(b.x)]) == gen, bar);
            __builtin_amdgcn_fence(__ATOMIC_ACQUIRE, "agent");
            asm volatile("s_waitcnt vmcnt(0)" ::: "memory");
        }
    }
    __syncthreads();
}

__device__ __forceinline__ void xcd_local_barrier(const XcdBarrier& b) {
    asm volatile("s_waitcnt vmcnt(0)" ::: "memory");
    __syncthreads();
    if (threadIdx.x == 0) {
        unsigned* bar = b.bar;
        __builtin_amdgcn_s_waitcnt(0);
        const unsigned nloc = b.st[0];
        const unsigned old = xb_add(&bar[XB_XSUB(b.x)], 1u);
        const unsigned gen = old / nloc;
        if (old + 1u == (gen + 1u) * nloc) xb_add(&bar[XB_XGEN(b.x)], 1u);
        else XB_SPIN(xb_ld(&bar[XB_XGEN(b.x)]) == gen, bar);
        __builtin_amdgcn_fence(__ATOMIC_ACQUIRE, "agent");
        asm volatile("s_waitcnt vmcnt(0)" ::: "memory");
    }
    __syncthreads();
}
__device__ __forceinline__ void ctr_signal(unsigned* ctr) {
    asm volatile("s_waitcnt vmcnt(0)" ::: "memory"); __syncthreads();
    if (threadIdx.x == 0) { __builtin_amdgcn_fence(__ATOMIC_RELEASE, "agent"); asm volatile("s_waitcnt vmcnt(0)" ::: "memory"); (void)xb_add(ctr, 1u); }
}
__device__ __forceinline__ void ctr_wait(unsigned* ctr, unsigned target, unsigned* bar) {
    if (threadIdx.x == 0) { XB_SPIN(xb_ld(ctr) < target, bar); __builtin_amdgcn_fence(__ATOMIC_ACQUIRE, "agent"); asm volatile("s_waitcnt vmcnt(0)" ::: "memory"); }
    __syncthreads();
}

constexpr int D = 1024, NB = 4, SEQ = 4096, NTOK = NB * SEQ, CTXL = 256, NCTX = NB * CTXL, NROW = NTOK + NCTX;
constexpr int RW = 512, NH = 8, HD = 64, RCOLS = 1920, INC = 4992, PRW_LD = 2048;
constexpr int NE = 32, TOPK = 4, ECAP = NTOK;
constexpr int NT = 512;
typedef float f4 __attribute__((ext_vector_type(4)));
typedef unsigned short bf16_t;
typedef unsigned u32x2 __attribute__((ext_vector_type(2)));
typedef unsigned u32x4 __attribute__((ext_vector_type(4)));
typedef short bf16x8_t __attribute__((ext_vector_type(8)));

typedef float f32x2_cv __attribute__((ext_vector_type(2)));
typedef __bf16 bf16x2_cv __attribute__((ext_vector_type(2)));
__device__ __forceinline__ unsigned cvt_pk_bf16(float lo, float hi) { return __builtin_bit_cast(unsigned, __builtin_convertvector((f32x2_cv){lo, hi}, bf16x2_cv)); }
__device__ __forceinline__ float bf_lo(unsigned w) { return __uint_as_float(w << 16); }
__device__ __forceinline__ float bf_hi(unsigned w) { return __uint_as_float(w & 0xffff0000u); }
__device__ __forceinline__ float bf2f(bf16_t b) { return __uint_as_float(((unsigned)b) << 16); }
__device__ __forceinline__ bf16_t f2bf(float f) { return (bf16_t)(cvt_pk_bf16(f, 0.f) & 0xffffu); }

constexpr size_t MiB = 1024 * 1024;
constexpr size_t WS_CTL = 0;
constexpr size_t CTL_BYTES = 65536;
constexpr size_t WS_MOD = WS_CTL + CTL_BYTES;
constexpr size_t WS_LIST = WS_MOD + 131072;
constexpr size_t WS_WGT = WS_LIST + (size_t)NE * ECAP * 4;
constexpr size_t WS_POS = 2 * MiB + 512 * 1024;
constexpr size_t WS_WRT = 3 * MiB;
constexpr size_t WS_GS2 = WS_WRT + 131072, WS_BIAS2 = WS_GS2 + 16384;
constexpr size_t WS_WINT = 4 * MiB;
constexpr size_t WS_WOR = 14 * MiB;
constexpr size_t WS_WOS = 15 * MiB;
constexpr size_t WS_WOT = 16 * MiB;
constexpr size_t WS_LORAT = 18 * MiB;
constexpr size_t WS_GA = 20 * MiB;
constexpr size_t WS_GSGU = 52 * MiB;
constexpr size_t WS_H = 84 * MiB;
constexpr size_t WS_PRW = 118 * MiB;
constexpr size_t WS_LW = 118 * MiB, WS_GB = 118 * MiB, WS_KD = 152 * MiB, WS_M = 320 * MiB;
constexpr size_t WS_R = 186 * MiB, WS_A = 203 * MiB, WS_AS = 203 * MiB;
constexpr size_t WS_B = 220 * MiB, WS_YD = 220 * MiB;
constexpr size_t WS_G = 254 * MiB, WS_V = 271 * MiB;
constexpr size_t WS_KRAW = 300 * MiB, WS_ALORA = 317 * MiB;
constexpr size_t WS_AR = 288 * MiB;
constexpr size_t WS_X1 = 52 * MiB, WS_H2 = 20 * MiB, WS_ACT = 148 * MiB;
constexpr size_t WS_SSP = 84 * MiB;
constexpr int CS_TILES = 64;
constexpr size_t WS_W1T = 384 * MiB;
constexpr size_t WS_END = 512 * MiB;
constexpr int CW_CTX = 4064;
constexpr int CW_CNT = 4096;
constexpr int ACT_ROWS = 65536 + 32 * 256;
static_assert(XCD_BAR_WORDS <= CW_CTX && CW_CTX < CW_CNT && (CW_CNT + 32) * 4 <= 20480, "ctl layout");
static_assert(WS_WGT + 65536 * 4 <= WS_POS && WS_POS + 65536 * 4 <= WS_WRT && WS_BIAS2 + 512 <= WS_WINT, "misc region");
static_assert((size_t)ACT_ROWS * 1024 * 2 <= 144 * MiB, "act region");

struct Args { const float* in[36]; float* out; unsigned char* ws; int ph_lo, ph_hi; };
struct Frame { const float* const* in; float* out; unsigned char* ws; LAS float* sm; LAS unsigned char* lds; int tid, lane, wave, G, bid; };

template <int CTRL> __device__ __forceinline__ float dpp_f(float x) { return __int_as_float(__builtin_amdgcn_update_dpp(0, __float_as_int(x), CTRL, 0xF, 0xF, false)); }
__device__ __forceinline__ float sum8(float x) { x += dpp_f<0xB1>(x); x += dpp_f<0x4E>(x); x += dpp_f<0x141>(x); return x; }
__device__ __forceinline__ float sum16(float x) { x = sum8(x); x += dpp_f<0x140>(x); return x; }
__device__ __forceinline__ float wave_sum(float v) {
    v = sum16(v);
    const int iv = __float_as_int(v);
    const float r0 = __int_as_float(__builtin_amdgcn_readlane(iv, 0)), r1 = __int_as_float(__builtin_amdgcn_readlane(iv, 16));
    const float r2 = __int_as_float(__builtin_amdgcn_readlane(iv, 32)), r3 = __int_as_float(__builtin_amdgcn_readlane(iv, 48));
    return (r0 + r1) + (r2 + r3);
}
__device__ __forceinline__ float sigmoid_acc(float x) { return 1.0f / (1.0f + expf(-x)); }
__device__ __forceinline__ float sigmoid_fast(float x) { return __builtin_amdgcn_rcpf(1.0f + __expf(-x)); }

namespace mg {
typedef short bf16x8 __attribute__((ext_vector_type(8)));
typedef float f32x4 __attribute__((ext_vector_type(4)));
typedef float f32x2 __attribute__((ext_vector_type(2)));
constexpr int BM = 256, BK = 64, HALF = 128, HTB = HALF * BK * 2, STAGE_BYTES = 8 * HTB, NXCD = 8, WGM = 4;
__device__ __forceinline__ int lds_byte(int r, int c) { const int st = (r >> 4) * 2 + (c >> 5), rr = r & 15, cc = c & 31, ob = rr * 64 + cc * 2; return st * 1024 + (ob ^ (((ob >> 9) & 1) << 5)); }
__device__ __forceinline__ void stage_rc(int b, int& R, int& C) { const int st = b / 1024, sb = b % 1024, swz = sb ^ (((sb >> 9) & 1) << 5); R = (st >> 1) * 16 + swz / 64; C = (st & 1) * 32 + (swz % 64) / 2; }
__device__ __forceinline__ int perm32(int rho) { const int n = rho >> 4, i = rho & 15; return 8 * (i >> 2) + 4 * n + (i & 3); }
struct Unit { int pm, pn, e, li; };

__device__ __forceinline__ f32x2 gelu_pk(f32x2 v) {
    const f32x2 av = __builtin_elementwise_abs(v), d = av * 0.2316418882f + 1.0f;
    f32x2 t; t.x = __builtin_amdgcn_rcpf(d.x); t.y = __builtin_amdgcn_rcpf(d.y);
    f32x2 q = t * 0.5307027145f + (-0.7265760135f); q = q * t + 0.7107068705f; q = q * t + (-0.142248368f); q = q * t + 0.127414796f; q = q * t;
    const f32x2 s = (v * v) * (-0.72134752044f);
    f32x2 e; e.x = __builtin_amdgcn_exp2f(s.x); e.y = __builtin_amdgcn_exp2f(s.y);
    const f32x2 m = v * (q * e), r = v - m;
    f32x2 o; o.x = v.x < 0.f ? m.x : r.x; o.y = v.y < 0.f ? m.y : r.y; return o;
}

__device__ __forceinline__ bool static_order(int L, int nM, int nN, Unit& u) {
    const int nwg = nM * nN; if (L >= nwg) return false;
    int wgid = L; { const int q = nwg / NXCD, r = nwg % NXCD, xcd = wgid % NXCD, off = wgid / NXCD; wgid = (xcd < r ? xcd * (q + 1) : r * (q + 1) + (xcd - r) * q) + off; }
    const int nig = WGM * nN, gid = wgid / nig, fm = gid * WGM, gsz = (nM - fm) < WGM ? (nM - fm) : WGM;
    u.pm = fm + ((wgid % nig) % gsz); u.pn = (wgid % nig) / gsz; u.e = 0; u.li = 0; return true;
}

template <class Prob, class Epi>
__device__ __forceinline__ void gemm_run(LAS unsigned char* lds, const Prob& P, const Epi& E) {
    const int tid = threadIdx.x, wid = __builtin_amdgcn_readfirstlane(tid >> 6), lane = tid & 63, wr = wid >> 2, wc = wid & 3, fr = lane & 15, fq = lane >> 4;
    const int K = P.K, nt = K / BK, ldb = P.ldb();
    int sR[2], sC[2]; unsigned voffB[2];
#pragma unroll
    for (int i = 0; i < 2; ++i) { int R, C; stage_rc(tid * 16 + i * 8192, R, C); sR[i] = R; sC[i] = C; const int Rb = Epi::PERM ? ((R & ~31) + perm32(R & 31)) : R; voffB[i] = (unsigned)(Rb * ldb + C) * 2u; }
    const size_t kstep = (size_t)(BK * 2);
    const size_t hstep = (size_t)HALF * ldb * 2;
    const unsigned ldsw = (unsigned)wid * 1024u;
    const int aoff = lds_byte(wr * 64 + fr, fq * 8), boff = lds_byte(wc * 32 + fr, fq * 8);
#define MG_SA(b, h) (((b) * 2 + (h)) * HTB)
#define MG_SB(b, h) ((4 + (b) * 2 + (h)) * HTB)
#define MG_STAGE(bufoff, gbase, voff) do { _Pragma("unroll") for (int _i = 0; _i < 2; ++_i) \
        __builtin_amdgcn_global_load_lds((const unsigned*)((const char*)(gbase) + (voff)[_i]), (LAS unsigned*)(lds + (bufoff) + ldsw + _i * 8192), 16, 0, 0); } while (0)
#define MG_LDA(dst, b, h) do { _Pragma("unroll") for (int m = 0; m < 4; ++m) _Pragma("unroll") for (int k = 0; k < 2; ++k) dst[m][k] = *(const LAS bf16x8*)(lds + MG_SA(b, h) + aoff + m * 2048 + k * 1024); } while (0)
#define MG_LDB(dst, b, h) do { _Pragma("unroll") for (int n = 0; n < 2; ++n) _Pragma("unroll") for (int k = 0; k < 2; ++k) dst[n][k] = *(const LAS bf16x8*)(lds + MG_SB(b, h) + boff + n * 2048 + k * 1024); } while (0)
#define MG_MMA(ai, bj, At, Bt) do { __builtin_amdgcn_s_setprio(1); _Pragma("unroll") for (int m = 0; m < 4; ++m) _Pragma("unroll") for (int n = 0; n < 2; ++n) _Pragma("unroll") for (int k = 0; k < 2; ++k) \
        acc[ai][bj][m][n] = __builtin_amdgcn_mfma_f32_16x16x32_bf16(Bt[n][k], At[m][k], acc[ai][bj][m][n], 0, 0, 0); __builtin_amdgcn_s_setprio(0); } while (0)
#define MG_WAIT_V(n) asm volatile("s_waitcnt vmcnt(" #n ")" ::: "memory")
#define MG_WAIT_L(n) asm volatile("s_waitcnt lgkmcnt(" #n ")" ::: "memory")
#define MG_BAR __builtin_amdgcn_s_barrier()
#define MG_SCHED __builtin_amdgcn_sched_barrier(0)
    Unit cur, nxt; int ui = 0;
    if (!P.next(0, cur)) return;
    f32x4 acc[2][2][4][2];
#pragma unroll
    for (int a = 0; a < 2; ++a)
#pragma unroll
        for (int b = 0; b < 2; ++b)
#pragma unroll
            for (int m = 0; m < 4; ++m)
#pragma unroll
                for (int n = 0; n < 2; ++n) acc[a][b][m][n] = (f32x4){0.f, 0.f, 0.f, 0.f};
    bf16x8 At[4][2], B0[2][2], B1[2][2];
    unsigned aoC[2][2], aoN[2][2];
    P.a_offs(cur, sR, sC, aoC);
    const char* const Ab = P.a_base();
    const char* cB = P.b_base(cur);
    MG_STAGE(MG_SB(0, 0), cB, voffB); MG_STAGE(MG_SA(0, 0), Ab, aoC[0]); MG_STAGE(MG_SB(0, 1), cB + hstep, voffB); MG_STAGE(MG_SA(0, 1), Ab, aoC[1]);
    if (wr == 1) MG_BAR;
    MG_WAIT_V(4); MG_BAR;
    MG_STAGE(MG_SB(1, 0), cB + kstep, voffB); MG_STAGE(MG_SA(1, 0), Ab + kstep, aoC[0]); MG_STAGE(MG_SB(1, 1), cB + hstep + kstep, voffB);
    MG_WAIT_V(6); MG_BAR;
    for (;;) {
        const bool has_next = P.next(ui + 1, nxt);
        const char* nB = cB;
        if (has_next) { P.a_offs(nxt, sR, sC, aoN); nB = P.b_base(nxt); }
        else { aoN[0][0] = aoC[0][0]; aoN[0][1] = aoC[0][1]; aoN[1][0] = aoC[1][0]; aoN[1][1] = aoC[1][1]; }
        for (int t = 0; t < nt; t += 2) {
            const bool last = (t == nt - 2);
            const char* a1 = Ab + (size_t)(t + 1) * kstep;
            const char* a2 = last ? Ab : Ab + (size_t)(t + 2) * kstep; const char* b2 = last ? nB : cB + (size_t)(t + 2) * kstep;
            const char* a3 = a2 + kstep; const char* b3 = b2 + kstep;
            unsigned o0[2], o1[2];
            o0[0] = last ? aoN[0][0] : aoC[0][0]; o0[1] = last ? aoN[0][1] : aoC[0][1]; o1[0] = last ? aoN[1][0] : aoC[1][0]; o1[1] = last ? aoN[1][1] : aoC[1][1];
            MG_LDB(B0, 0, 0); MG_SCHED; MG_LDA(At, 0, 0); MG_STAGE(MG_SA(1, 1), a1, aoC[1]);
            MG_WAIT_L(8); MG_BAR; MG_WAIT_L(0); MG_MMA(0, 0, At, B0); MG_BAR; MG_SCHED;
            MG_LDB(B1, 0, 1); MG_STAGE(MG_SB(0, 0), b2, voffB);
            MG_BAR; MG_WAIT_L(0); MG_MMA(0, 1, At, B1); MG_BAR;
            MG_LDA(At, 0, 1); MG_STAGE(MG_SA(0, 0), a2, o0);
            MG_BAR; MG_WAIT_L(0); MG_MMA(1, 0, At, B0); MG_BAR; MG_SCHED;
            MG_STAGE(MG_SB(0, 1), b2 + hstep, voffB);
            MG_WAIT_V(6); MG_BAR; MG_MMA(1, 1, At, B1); MG_BAR;
            MG_LDB(B0, 1, 0); MG_SCHED; MG_LDA(At, 1, 0); MG_STAGE(MG_SA(0, 1), a2, o1);
            MG_WAIT_L(8); MG_BAR; MG_WAIT_L(0); MG_MMA(0, 0, At, B0); MG_BAR; MG_SCHED;
            MG_LDB(B1, 1, 1); MG_STAGE(MG_SB(1, 0), b3, voffB);
            MG_BAR; MG_WAIT_L(0); MG_MMA(0, 1, At, B1); MG_BAR;
            MG_LDA(At, 1, 1); MG_STAGE(MG_SA(1, 0), a3, o0);
            MG_BAR; MG_WAIT_L(0); MG_MMA(1, 0, At, B0); MG_BAR; MG_SCHED;
            MG_STAGE(MG_SB(1, 1), b3 + hstep, voffB);
            MG_WAIT_V(6); MG_BAR; MG_MMA(1, 1, At, B1); MG_BAR;
        }
        MG_SCHED; asm volatile("s_nop 15\n\ts_nop 7" ::: "memory"); MG_SCHED;
        E(acc, cur, wr, wc, fr, fq);
        if (!has_next) break;
#pragma unroll
        for (int a = 0; a < 2; ++a)
#pragma unroll
            for (int b = 0; b < 2; ++b)
#pragma unroll
                for (int m = 0; m < 4; ++m)
#pragma unroll
                    for (int n = 0; n < 2; ++n) acc[a][b][m][n] = (f32x4){0.f, 0.f, 0.f, 0.f};
        cur = nxt; cB = nB; ++ui;
        aoC[0][0] = aoN[0][0]; aoC[0][1] = aoN[0][1]; aoC[1][0] = aoN[1][0]; aoC[1][1] = aoN[1][1];
    }
    MG_WAIT_V(0);
    if (wr == 0) MG_BAR;
    MG_BAR;
#undef MG_SA
#undef MG_SB
#undef MG_STAGE
#undef MG_LDA
#undef MG_LDB
#undef MG_MMA
#undef MG_WAIT_V
#undef MG_WAIT_L
#undef MG_BAR
#undef MG_SCHED
}

struct DenseProb {
    const bf16_t* A; const bf16_t* Bt; int nM, nN, K, G, c;
    __device__ __forceinline__ int ldb() const { return K; }
    __device__ __forceinline__ bool next(int i, Unit& u) const { return static_order(i * G + c, nM, nN, u); }
    __device__ __forceinline__ const char* a_base() const { return (const char*)A; }
    __device__ __forceinline__ const char* b_base(const Unit& u) const { return (const char*)Bt + (size_t)u.pn * BM * K * 2; }
    __device__ __forceinline__ void a_offs(const Unit& u, const int (&sR)[2], const int (&sC)[2], unsigned (&o)[2][2]) const {
#pragma unroll
        for (int h = 0; h < 2; ++h)
#pragma unroll
            for (int i = 0; i < 2; ++i) o[h][i] = (unsigned)((u.pm * BM + h * HALF + sR[i]) * K + sC[i]) * 2u; }
};
struct PProb {
    const bf16_t* A; const bf16_t* Bt; int G, c, lo, hi; static constexpr int K = 1024;
    __device__ __forceinline__ int ldb() const { return K; }
    __device__ __forceinline__ bool next(int i, Unit& u) const { const int L = lo + i * G + c; if (L >= hi) return false; if (L < 1024) { static_order(L, 64, 16, u);
            if (G == 256 && (L >> 8) == 3 && u.pn >= 8) u.pn = 8 + ((u.pn - 8 + 4) & 7);
            return true; }
        const int t = L - 1024; u.pm = 64 + (t >> 3); u.pn = t & 7; u.e = 0; u.li = 0; return true; }
    __device__ __forceinline__ const char* a_base() const { return (const char*)A; }
    __device__ __forceinline__ const char* b_base(const Unit& u) const { return (const char*)Bt + (size_t)u.pn * BM * K * 2; }
    __device__ __forceinline__ void a_offs(const Unit& u, const int (&sR)[2], const int (&sC)[2], unsigned (&o)[2][2]) const {
#pragma unroll
        for (int h = 0; h < 2; ++h)
#pragma unroll
            for (int i = 0; i < 2; ++i) o[h][i] = (unsigned)((u.pm * BM + h * HALF + sR[i]) * K + sC[i]) * 2u; }
};
struct YYProb {
    const bf16_t* As; const bf16_t* Ar; const bf16_t* WoS; const bf16_t* WoR; int G, c; static constexpr int K = 512;
    __device__ __forceinline__ int ldb() const { return K; }
    __device__ __forceinline__ bool next(int i, Unit& u) const { if (i >= 2) return false; if (!static_order(c, 64, 4, u)) return false; u.e = i; u.li = i; return true; }
    __device__ __forceinline__ const char* a_base() const { return (const char*)As; }
    __device__ __forceinline__ const char* b_base(const Unit& u) const { return (const char*)(u.e ? WoR : WoS) + (size_t)u.pn * BM * K * 2; }
    __device__ __forceinline__ void a_offs(const Unit& u, const int (&sR)[2], const int (&sC)[2], unsigned (&o)[2][2]) const {
        const unsigned d = u.e ? (unsigned)((const char*)Ar - (const char*)As) : 0u;
#pragma unroll
        for (int h = 0; h < 2; ++h)
#pragma unroll
            for (int i = 0; i < 2; ++i) o[h][i] = d + (unsigned)((u.pm * BM + h * HALF + sR[i]) * K + sC[i]) * 2u; }
};
struct LoraProb {
    const bf16_t* A; const bf16_t* Bt; int G, c; static constexpr int K = 128;
    __device__ __forceinline__ int ldb() const { return 384; }
    __device__ __forceinline__ bool next(int i, Unit& u) const { if (G != 256) return static_order(i * G + c, 68, 10, u);
        int cls, q;
        if (c < 88) { if (i > 1) return false; cls = 0; q = 2 * c + i; }
        else if (c < 184) { if (i > 2) return false; const int w = c - 88; cls = i; q = i == 0 ? 176 + w : w; }
        else if (c < 216) { if (i > 2) return false; cls = 1; q = 96 + 3 * (c - 184) + i; }
        else { if (i > 2) return false; const int w = c - 216; cls = i < 2 ? 1 : 2; q = i < 2 ? 192 + 2 * w + i : 96 + w; }
        if (cls == 0) { u.pm = q >> 2; u.pn = 4 + (q & 3); } else if (cls == 1) { u.pm = q >> 2; u.pn = q & 3; } else { u.pm = q >> 1; u.pn = 8 + (q & 1); }
        u.e = 0; u.li = 0; return true; }
    __device__ __forceinline__ int koff(const Unit& u) const { return u.pn < 4 ? 0 : (u.pn < 8 ? 128 : 256); }
    __device__ __forceinline__ const char* a_base() const { return (const char*)A; }
    __device__ __forceinline__ const char* b_base(const Unit& u) const { return (const char*)Bt + ((size_t)u.pn * BM * 384 + koff(u)) * 2; }
    __device__ __forceinline__ void a_offs(const Unit& u, const int (&sR)[2], const int (&sC)[2], unsigned (&o)[2][2]) const {
        const int ko = koff(u);
#pragma unroll
        for (int h = 0; h < 2; ++h)
#pragma unroll
            for (int i = 0; i < 2; ++i) o[h][i] = (unsigned)((u.pm * BM + h * HALF + sR[i]) * 384 + ko + sC[i]) * 2u; }
};
__device__ __forceinline__ int moe_expert_of(LAS const int* tb, int rt) { int e = 0;
#pragma unroll
    for (int i = 1; i < NE; ++i) e = (tb[32 + i] <= rt) ? i : e;
    return e; }
struct Moe1Prob {
    const bf16_t* H2; const bf16_t* W1t; const int* lst; LAS const int* tb; LAS const int* tok; int G, c, i_lo, i_hi; static constexpr int K = 1024;
    __device__ __forceinline__ int ldb() const { return K; }
    __device__ __forceinline__ bool next(int i_, Unit& u) const { const int RT = tb[65]; int rt, ct; const int i = i_lo + i_; if (i >= i_hi) return false;
        if (G == 256) { const int xcd = c & 7, r = c >> 3, s = i * 8 + xcd; rt = 4 * s + (r & 3); ct = r >> 2; } else { const int L = i * G + c; rt = L >> 3; ct = L & 7; }
        if (rt >= RT) return false; u.pm = rt; u.pn = ct; u.e = moe_expert_of(tb, rt); u.li = i_; return true; }
    __device__ __forceinline__ const char* a_base() const { return (const char*)H2; }
    __device__ __forceinline__ const char* b_base(const Unit& u) const { return (const char*)W1t + ((size_t)u.e * 2048 + (size_t)u.pn * 256) * K * 2; }
    __device__ __forceinline__ void a_offs(const Unit& u, const int (&sR)[2], const int (&sC)[2], unsigned (&o)[2][2]) const {
#pragma unroll
        for (int h = 0; h < 2; ++h)
#pragma unroll
            for (int i = 0; i < 2; ++i) o[h][i] = (unsigned)(tok[u.li * 256 + h * HALF + sR[i]] * K + sC[i]) * 2u; }
    __device__ __forceinline__ void fill(LAS int* tw, int* pos) const {
        Unit u;
        for (int i = 0; next(i, u); ++i) { if (i >= 12) break;
            const int g0 = (u.pm - tb[32 + u.e]) * 256, cnt = tb[u.e];
            if (threadIdx.x < 256) { const int gi = g0 + threadIdx.x; int tk = 0; if (gi < cnt) { const int as = lst[(size_t)u.e * ECAP + gi]; tk = as >> 2; if (u.pn == 0) pos[as] = u.pm * 256 + threadIdx.x; } tw[i * 256 + threadIdx.x] = tk; } }
        __syncthreads(); }
};
struct Moe2Prob {
    const bf16_t* Act; const bf16_t* W2t; LAS const int* tb; int G, c, s0, single; static constexpr int K = 1024;
    __device__ __forceinline__ int ldb() const { return K; }
    __device__ __forceinline__ bool next(int i, Unit& u) const { const int RT = tb[65]; int rt, ct;
        if (single >= 0) { if (i > 0) return false; const int sB = single >> 5, q = single & 31; rt = 8 * sB + (q & 7); ct = q >> 3; }
        else if (G == 256) { const int xcd = c & 7, r = c >> 3, s = s0 + i * 8 + xcd; rt = 8 * s + (r & 7); ct = r >> 3; } else { const int L = s0 * 32 + i * G + c; rt = L >> 2; ct = L & 3; }
        if (rt >= RT) return false; u.pm = rt; u.pn = ct; u.e = moe_expert_of(tb, rt); u.li = i; return true; }
    __device__ __forceinline__ const char* a_base() const { return (const char*)Act; }
    __device__ __forceinline__ const char* b_base(const Unit& u) const { return (const char*)W2t + ((size_t)u.e * 1024 + (size_t)u.pn * 256) * K * 2; }
    __device__ __forceinline__ void a_offs(const Unit& u, const int (&sR)[2], const int (&sC)[2], unsigned (&o)[2][2]) const {
#pragma unroll
        for (int h = 0; h < 2; ++h)
#pragma unroll
            for (int i = 0; i < 2; ++i) o[h][i] = (unsigned)((u.pm * BM + h * HALF + sR[i]) * K + sC[i]) * 2u; }
};

struct EpiP {
    static constexpr bool PERM = true;
    bf16_t* Prw; bf16_t* Gsgu; bf16_t* GateA;
    __device__ __forceinline__ void operator()(const f32x4 (&acc)[2][2][4][2], const Unit& u, int wr, int wc, int fr, int fq) const {
        const int row0 = u.pm * BM + wr * 64 + fr, colt = wc * 32 + 8 * fq;
        bf16_t* base; int ld, mode;
        if (u.pn < 8) { base = Prw + u.pn * 256; ld = PRW_LD; mode = 0; }
        else if (u.pn < 12) { base = Gsgu + (u.pn - 8) * 256; ld = 1024; mode = 1; }
        else { base = GateA + (u.pn - 12) * 256; ld = 1024; mode = 2; }
#pragma unroll
        for (int ai = 0; ai < 2; ++ai)
#pragma unroll
            for (int m = 0; m < 4; ++m) { bf16_t* rowp = base + (size_t)(row0 + ai * HALF + m * 16) * ld + colt;
#pragma unroll
                for (int bj = 0; bj < 2; ++bj) { f32x4 v0 = acc[ai][bj][m][0], v1 = acc[ai][bj][m][1];
                    if (mode == 1) { const f32x2 a = gelu_pk((f32x2){v0[0], v0[1]}), b = gelu_pk((f32x2){v0[2], v0[3]}), c = gelu_pk((f32x2){v1[0], v1[1]}), d = gelu_pk((f32x2){v1[2], v1[3]});
                        v0 = (f32x4){a.x, a.y, b.x, b.y}; v1 = (f32x4){c.x, c.y, d.x, d.y}; }
                    if (mode == 2) {
#pragma unroll
                        for (int j = 0; j < 4; ++j) { v0[j] = sigmoid_fast(v0[j]); v1[j] = sigmoid_fast(v1[j]); } }
                    u32x4 w; w.x = cvt_pk_bf16(v0[0], v0[1]); w.y = cvt_pk_bf16(v0[2], v0[3]); w.z = cvt_pk_bf16(v1[0], v1[1]); w.w = cvt_pk_bf16(v1[2], v1[3]);
                    *(u32x4*)(rowp + bj * HALF) = w; } }
    }
};
struct EpiSig {
    static constexpr bool PERM = true;
    bf16_t* O;
    __device__ __forceinline__ void operator()(const f32x4 (&acc)[2][2][4][2], const Unit& u, int wr, int wc, int fr, int fq) const {
        const int row0 = u.pm * BM + wr * 64 + fr, col0 = u.pn * BM + wc * 32 + 8 * fq;
#pragma unroll
        for (int ai = 0; ai < 2; ++ai)
#pragma unroll
            for (int m = 0; m < 4; ++m) { bf16_t* rowp = O + (size_t)(row0 + ai * HALF + m * 16) * 1024 + col0;
#pragma unroll
                for (int bj = 0; bj < 2; ++bj) { f32x4 v0 = acc[ai][bj][m][0], v1 = acc[ai][bj][m][1];
#pragma unroll
                    for (int j = 0; j < 4; ++j) { v0[j] = sigmoid_fast(v0[j]); v1[j] = sigmoid_fast(v1[j]); }
                    u32x4 w; w.x = cvt_pk_bf16(v0[0], v0[1]); w.y = cvt_pk_bf16(v0[2], v0[3]); w.z = cvt_pk_bf16(v1[0], v1[1]); w.w = cvt_pk_bf16(v1[2], v1[3]);
                    *(u32x4*)(rowp + bj * HALF) = w; } }
    }
};
template <bool ACCUM> struct EpiGateMul {
    static constexpr bool PERM = true;
    bf16_t* Mo; const bf16_t* gate;
    __device__ __forceinline__ void operator()(const f32x4 (&acc)[2][2][4][2], const Unit& u, int wr, int wc, int fr, int fq) const {
        const int row0 = u.pm * BM + wr * 64 + fr, col0 = u.pn * BM + wc * 32 + 8 * fq;
#pragma unroll
        for (int ai = 0; ai < 2; ++ai) {
            u32x4 gq[4][2], pq[4][2];
#pragma unroll
            for (int m = 0; m < 4; ++m)
#pragma unroll
                for (int bj = 0; bj < 2; ++bj) { const size_t ro = (size_t)(row0 + ai * HALF + m * 16) * 1024 + col0 + bj * HALF;
                    gq[m][bj] = *(const u32x4*)(gate + ro); if (ACCUM) pq[m][bj] = *(const u32x4*)(Mo + ro); }
#pragma unroll
            for (int m = 0; m < 4; ++m) { const size_t ro = (size_t)(row0 + ai * HALF + m * 16) * 1024 + col0;
#pragma unroll
                for (int bj = 0; bj < 2; ++bj) { const f32x4 v0 = acc[ai][bj][m][0], v1 = acc[ai][bj][m][1];
                    const u32x4 g = gq[m][bj];
                    float o[8] = {bf_lo(g.x) * v0[0], bf_hi(g.x) * v0[1], bf_lo(g.y) * v0[2], bf_hi(g.y) * v0[3], bf_lo(g.z) * v1[0], bf_hi(g.z) * v1[1], bf_lo(g.w) * v1[2], bf_hi(g.w) * v1[3]};
                    if (ACCUM) { const u32x4 p = pq[m][bj];
                        o[0] += bf_lo(p.x); o[1] += bf_hi(p.x); o[2] += bf_lo(p.y); o[3] += bf_hi(p.y); o[4] += bf_lo(p.z); o[5] += bf_hi(p.z); o[6] += bf_lo(p.w); o[7] += bf_hi(p.w); }
                    u32x4 w; w.x = cvt_pk_bf16(o[0], o[1]); w.y = cvt_pk_bf16(o[2], o[3]); w.z = cvt_pk_bf16(o[4], o[5]); w.w = cvt_pk_bf16(o[6], o[7]);
                    *(u32x4*)(Mo + ro + bj * HALF) = w; } } }
    }
};
struct EpiYY {
    static constexpr bool PERM = true;
    bf16_t* Mo; const bf16_t* gateA; const bf16_t* gateB;
    __device__ __forceinline__ void operator()(const f32x4 (&acc)[2][2][4][2], const Unit& u, int wr, int wc, int fr, int fq) const {
        if (u.e == 0) { EpiGateMul<false> E{Mo, gateB}; E(acc, u, wr, wc, fr, fq); } else { EpiGateMul<true> E{Mo, gateA}; E(acc, u, wr, wc, fr, fq); }
    }
};
struct EpiX1 {
    static constexpr bool PERM = true;
    bf16_t* x1; const float* x; const float* mod; float* ssp;
    __device__ __forceinline__ void operator()(const f32x4 (&acc)[2][2][4][2], const Unit& u, int wr, int wc, int fr, int fq) const {
        const int row0 = u.pm * BM + wr * 64 + fr, col0 = u.pn * BM + wc * 32 + 8 * fq;
        const float* gp = mod + (size_t)((u.pm * BM) / SEQ) * 6144 + 2048 + col0;
        f32x4 gv[2][2];
#pragma unroll
        for (int bj = 0; bj < 2; ++bj)
#pragma unroll
            for (int n = 0; n < 2; ++n) gv[bj][n] = *(const f32x4*)(gp + bj * HALF + 4 * n);
#pragma unroll
        for (int ai = 0; ai < 2; ++ai) {
            f32x4 xq[4][2][2];
#pragma unroll
            for (int m = 0; m < 4; ++m)
#pragma unroll
                for (int bj = 0; bj < 2; ++bj) { const size_t ro = (size_t)(row0 + ai * HALF + m * 16) * D + col0 + bj * HALF; xq[m][bj][0] = *(const f32x4*)(x + ro); xq[m][bj][1] = *(const f32x4*)(x + ro + 4); }
#pragma unroll
            for (int m = 0; m < 4; ++m) { const size_t ro = (size_t)(row0 + ai * HALF + m * 16) * D + col0; float sq = 0.f;
#pragma unroll
                for (int bj = 0; bj < 2; ++bj) { const f32x4 x0 = xq[m][bj][0], x1v = xq[m][bj][1];
                    const f32x4 o0 = x0 + gv[bj][0] * acc[ai][bj][m][0], o1 = x1v + gv[bj][1] * acc[ai][bj][m][1];
                    sq += ((o0[0] * o0[0] + o0[1] * o0[1]) + (o0[2] * o0[2] + o0[3] * o0[3])) + ((o1[0] * o1[0] + o1[1] * o1[1]) + (o1[2] * o1[2] + o1[3] * o1[3]));
                    u32x4 w; w.x = cvt_pk_bf16(o0[0], o0[1]); w.y = cvt_pk_bf16(o0[2], o0[3]); w.z = cvt_pk_bf16(o1[0], o1[1]); w.w = cvt_pk_bf16(o1[2], o1[3]);
                    *(u32x4*)(x1 + ro + bj * HALF) = w; }
                sq += __shfl_xor(sq, 16); sq += __shfl_xor(sq, 32);
                if (fq == 0) ssp[(size_t)(row0 + ai * HALF + m * 16) * 16 + u.pn * 4 + wc] = sq; } }
    }
};
struct EpiMoe1 {
    static constexpr bool PERM = true;
    bf16_t* act; const float* bg; const float* bu;
    __device__ __forceinline__ void operator()(const f32x4 (&acc)[2][2][4][2], const Unit& u, int wr, int wc, int fr, int fq) const {
        const int row0 = u.pm * BM + wr * 64 + fr, col0 = u.pn * 128 + wc * 32 + 8 * fq;
        f32x4 bgv[2], buv[2];
#pragma unroll
        for (int n = 0; n < 2; ++n) { bgv[n] = *(const f32x4*)(bg + u.e * 1024 + col0 + 4 * n); buv[n] = *(const f32x4*)(bu + u.e * 1024 + col0 + 4 * n); }
#pragma unroll
        for (int ai = 0; ai < 2; ++ai)
#pragma unroll
            for (int m = 0; m < 4; ++m) { float o[8];
#pragma unroll
                for (int n = 0; n < 2; ++n) { const f32x4 g4 = acc[ai][0][m][n] + bgv[n], u4 = acc[ai][1][m][n] + buv[n];
#pragma unroll
                    for (int j = 0; j < 4; ++j) { const float g = fminf(g4[j], 7.0f), uu = fminf(fmaxf(u4[j], -7.0f), 7.0f); o[n * 4 + j] = g * sigmoid_fast(1.702f * g) * (uu + 1.0f); } }
                u32x4 w; w.x = cvt_pk_bf16(o[0], o[1]); w.y = cvt_pk_bf16(o[2], o[3]); w.z = cvt_pk_bf16(o[4], o[5]); w.w = cvt_pk_bf16(o[6], o[7]);
                *(u32x4*)(act + (size_t)(row0 + ai * HALF + m * 16) * 1024 + col0) = w; }
    }
};
struct EpiMoe2 {
    static constexpr bool PERM = true;
    bf16_t* ys; const float* bd;
    __device__ __forceinline__ void operator()(const f32x4 (&acc)[2][2][4][2], const Unit& u, int wr, int wc, int fr, int fq) const {
        const int row0 = u.pm * BM + wr * 64 + fr, col0 = u.pn * BM + wc * 32 + 8 * fq;
        f32x4 bv[2][2];
#pragma unroll
        for (int bj = 0; bj < 2; ++bj)
#pragma unroll
            for (int n = 0; n < 2; ++n) bv[bj][n] = *(const f32x4*)(bd + u.e * 1024 + col0 + bj * HALF + 4 * n);
#pragma unroll
        for (int ai = 0; ai < 2; ++ai)
#pragma unroll
            for (int m = 0; m < 4; ++m) { bf16_t* rowp = ys + (size_t)(row0 + ai * HALF + m * 16) * 1024 + col0;
#pragma unroll
                for (int bj = 0; bj < 2; ++bj) { const f32x4 v0 = acc[ai][bj][m][0] + bv[bj][0], v1 = acc[ai][bj][m][1] + bv[bj][1];
                    u32x4 o; o.x = cvt_pk_bf16(v0[0], v0[1]); o.y = cvt_pk_bf16(v0[2], v0[3]); o.z = cvt_pk_bf16(v1[0], v1[1]); o.w = cvt_pk_bf16(v1[2], v1[3]);
                    *(u32x4*)(rowp + bj * HALF) = o; } }
    }
};
template <class Prob> __device__ __forceinline__ void moe2_fill(const Prob& P, LAS const int* tb, const int* lst, const float* wgt, LAS int* tw) {
    Unit u;
    for (int i = 0; P.next(i, u); ++i) { if (i >= 6) break;
        const int g0 = (u.pm - tb[32 + u.e]) * 256, cnt = tb[u.e];
        if (threadIdx.x < 256) { const int gi = g0 + threadIdx.x; int as = -1; float w = 0.f; if (gi < cnt) { as = lst[(size_t)u.e * ECAP + gi]; w = wgt[as]; }
            tw[(i * 256 + threadIdx.x) * 2] = as; tw[(i * 256 + threadIdx.x) * 2 + 1] = __float_as_int(w); } }
    __syncthreads(); }
struct EpiLora {
    static constexpr bool PERM = true;
    bf16_t* LW; bf16_t* KD; bf16_t* Bd; bf16_t* G; const bf16_t* Kraw; const bf16_t* A; const float* w0; const float* a0; const float* k_a;
    __device__ __forceinline__ void operator()(const f32x4 (&acc)[2][2][4][2], const Unit& u, int wr, int wc, int fr, int fq) const {
        const int row0 = u.pm * BM + wr * 64 + fr, ch0 = (u.pn & 1) * 256 + wc * 32 + 8 * fq, type = u.pn >> 1, d = type & 1;
        const size_t dofs = (size_t)d * NROW * RW;
#pragma unroll
        for (int bj = 0; bj < 2; ++bj) { const int ch = ch0 + bj * HALF;
            if (type < 2) { const f32x4 wv0 = *(const f32x4*)(w0 + d * RW + ch), wv1 = *(const f32x4*)(w0 + d * RW + ch + 4);
#pragma unroll
                for (int ai = 0; ai < 2; ++ai)
#pragma unroll
                    for (int m = 0; m < 4; ++m) { const f32x4 x0 = acc[ai][bj][m][0] + wv0, x1 = acc[ai][bj][m][1] + wv1; float o[8];
#pragma unroll
                        for (int j = 0; j < 4; ++j) { o[j] = -0.6065306597f * sigmoid_fast(x0[j]); o[4 + j] = -0.6065306597f * sigmoid_fast(x1[j]); }
                        u32x4 w; w.x = cvt_pk_bf16(o[0], o[1]); w.y = cvt_pk_bf16(o[2], o[3]); w.z = cvt_pk_bf16(o[4], o[5]); w.w = cvt_pk_bf16(o[6], o[7]);
                        *(u32x4*)(LW + dofs + (size_t)(row0 + ai * HALF + m * 16) * RW + ch) = w; }
            } else if (type < 4) { const f32x4 av0 = *(const f32x4*)(a0 + d * RW + ch), av1 = *(const f32x4*)(a0 + d * RW + ch + 4), ka0 = *(const f32x4*)(k_a + ch), ka1 = *(const f32x4*)(k_a + ch + 4);
                u32x4 kwa[2][4];
#pragma unroll
                for (int ai = 0; ai < 2; ++ai)
#pragma unroll
                    for (int m = 0; m < 4; ++m) kwa[ai][m] = *(const u32x4*)(Kraw + (size_t)(row0 + ai * HALF + m * 16) * RW + ch);
#pragma unroll
                for (int ai = 0; ai < 2; ++ai) {
#pragma unroll
                    for (int m = 0; m < 4; ++m) { const size_t ro = (size_t)(row0 + ai * HALF + m * 16) * RW + ch;
                        const f32x4 x0 = acc[ai][bj][m][0] + av0, x1 = acc[ai][bj][m][1] + av1; const u32x4 kww = kwa[ai][m];
                        const float kr[8] = {bf_lo(kww.x), bf_hi(kww.x), bf_lo(kww.y), bf_hi(kww.y), bf_lo(kww.z), bf_hi(kww.z), bf_lo(kww.w), bf_hi(kww.w)};
                        float okd[8], ob[8];
#pragma unroll
                        for (int j = 0; j < 4; ++j) { const float s0 = sigmoid_fast(x0[j]), s1 = sigmoid_fast(x1[j]);
                            okd[j] = kr[j] * (1.0f + (s0 - 1.0f) * ka0[j]); ob[j] = s0; okd[4 + j] = kr[4 + j] * (1.0f + (s1 - 1.0f) * ka1[j]); ob[4 + j] = s1; }
                        u32x4 w1, w2; w1.x = cvt_pk_bf16(okd[0], okd[1]); w1.y = cvt_pk_bf16(okd[2], okd[3]); w1.z = cvt_pk_bf16(okd[4], okd[5]); w1.w = cvt_pk_bf16(okd[6], okd[7]);
                        w2.x = cvt_pk_bf16(ob[0], ob[1]); w2.y = cvt_pk_bf16(ob[2], ob[3]); w2.z = cvt_pk_bf16(ob[4], ob[5]); w2.w = cvt_pk_bf16(ob[6], ob[7]);
                        *(u32x4*)(KD + dofs + ro) = w1; *(u32x4*)(Bd + dofs + ro) = w2; }
                }
            } else {
#pragma unroll
                for (int ai = 0; ai < 2; ++ai)
#pragma unroll
                    for (int m = 0; m < 4; ++m) { const f32x4 x0 = acc[ai][bj][m][0], x1 = acc[ai][bj][m][1];
                        u32x4 w; w.x = cvt_pk_bf16(x0[0], x0[1]); w.y = cvt_pk_bf16(x0[2], x0[3]); w.z = cvt_pk_bf16(x1[0], x1[1]); w.w = cvt_pk_bf16(x1[2], x1[3]);
                        *(u32x4*)(G + (size_t)(row0 + ai * HALF + m * 16) * RW + ch) = w; }
            } }
    }
};
}

constexpr int CV_LDB = 272;
__device__ __forceinline__ void cvt_tile(const Frame& F, const float* src, int ldw, bf16_t* dst, int ldd) {
    LAS unsigned char* ts = F.lds;
    const int nq = F.tid & 31, kg = F.tid >> 5;
    f4 v[8];
#pragma unroll
    for (int j = 0; j < 8; ++j) v[j] = *(const f4*)(src + (size_t)(kg * 8 + j) * ldw + nq * 4);
    __syncthreads();
#pragma unroll
    for (int c = 0; c < 4; ++c) { u32x4 w; w.x = cvt_pk_bf16(v[0][c], v[1][c]); w.y = cvt_pk_bf16(v[2][c], v[3][c]); w.z = cvt_pk_bf16(v[4][c], v[5][c]); w.w = cvt_pk_bf16(v[6][c], v[7][c]);
        *(LAS u32x4*)(ts + (nq * 4 + c) * CV_LDB + kg * 16) = w; }
    __syncthreads();
#pragma unroll
    for (int it = 0; it < 4; ++it) { const int slot = it * NT + F.tid, kq = slot & 15, n = slot >> 4;
        const u32x4 w = *(LAS u32x4*)(ts + n * CV_LDB + kq * 16);
        *(u32x4*)(dst + (size_t)n * ldd + kq * 8) = w; }
}
constexpr int CVS_TILES = 312 + 32 + 32 + 64;
__device__ __forceinline__ void cvs_addr(const Frame& F, int t, const float*& src, int& ldw, bf16_t*& dst, int& ldd) {
    bf16_t* WinT = (bf16_t*)(F.ws + WS_WINT); bf16_t* WoR = (bf16_t*)(F.ws + WS_WOR); bf16_t* WoS = (bf16_t*)(F.ws + WS_WOS); bf16_t* WoT = (bf16_t*)(F.ws + WS_WOT);
    if (t < 312) { const int kt = t / 39, ntl = t % 39, n0 = ntl * 128, r0 = n0 < 1920 ? n0 : n0 + 128;
        src = F.in[7] + (size_t)kt * 128 * INC + n0; ldw = INC; dst = WinT + (size_t)r0 * 1024 + kt * 128; ldd = 1024; }
    else if (t < 376) { const int j = (t - 312) & 31, kt = j >> 3, ntl = j & 7; const bool sg = t >= 344;
        src = (sg ? F.in[24] : F.in[19]) + (size_t)kt * 128 * 1024 + ntl * 128; ldw = 1024; dst = (sg ? WoS : WoR) + (size_t)ntl * 128 * 512 + kt * 128; ldd = 512; }
    else { const int j = t - 376, kt = j >> 3, ntl = j & 7;
        src = F.in[25] + (size_t)kt * 128 * 1024 + ntl * 128; ldw = 1024; dst = WoT + (size_t)ntl * 128 * 1024 + kt * 128; ldd = 1024; }
}
__device__ __forceinline__ void cvs_load(const Frame& F, int t, f4 (&v)[8]) {
    const float* src; int ldw; bf16_t* dst; int ldd; cvs_addr(F, t, src, ldw, dst, ldd);
    const int nq = F.tid & 31, kg = F.tid >> 5;
#pragma unroll
    for (int j = 0; j < 8; ++j) v[j] = *(const f4*)(src + (size_t)(kg * 8 + j) * ldw + nq * 4);
}
__device__ __forceinline__ void cvs_store(const Frame& F, int t, const f4 (&v)[8]) {
    const float* src; int ldw; bf16_t* dst; int ldd; cvs_addr(F, t, src, ldw, dst, ldd);
    LAS unsigned char* ts = F.lds;
    const int nq = F.tid & 31, kg = F.tid >> 5;
    __syncthreads();
#pragma unroll
    for (int c = 0; c < 4; ++c) { u32x4 w; w.x = cvt_pk_bf16(v[0][c], v[1][c]); w.y = cvt_pk_bf16(v[2][c], v[3][c]); w.z = cvt_pk_bf16(v[4][c], v[5][c]); w.w = cvt_pk_bf16(v[6][c], v[7][c]);
        *(LAS u32x4*)(ts + (nq * 4 + c) * CV_LDB + kg * 16) = w; }
    __syncthreads();
#pragma unroll
    for (int it = 0; it < 4; ++it) { const int slot = it * NT + F.tid, kq = slot & 15, n = slot >> 4;
        const u32x4 w = *(LAS u32x4*)(ts + n * CV_LDB + kq * 16);
        *(u32x4*)(dst + (size_t)n * ldd + kq * 8) = w; }
}
__device__ __forceinline__ void cvt_ex_addr(const Frame& F, int t, const float*& src, bf16_t*& dst) {
    const int e = t >> 7, j = t & 127, up = j >> 6, kt = (j & 63) >> 3, ntl = j & 7;
    src = (up ? F.in[31] : F.in[29]) + (size_t)e * D * D + (size_t)kt * 128 * D + ntl * 128;
    dst = (bf16_t*)(F.ws + WS_W1T) + ((size_t)e * 2048 + ntl * 256 + (up ? 128 : 0)) * 1024 + kt * 128;
}
__device__ __forceinline__ void cvt_ex_load(const Frame& F, int t, f4 (&v)[8]) {
    const float* src; bf16_t* dst; cvt_ex_addr(F, t, src, dst);
    const int nq = F.tid & 31, kg = F.tid >> 5;
#pragma unroll
    for (int j = 0; j < 8; ++j) v[j] = *(const f4*)(src + (size_t)(kg * 8 + j) * D + nq * 4);
}
__device__ __forceinline__ void cvt_ex_store(const Frame& F, int t, const f4 (&v)[8]) {
    const float* src; bf16_t* dst; cvt_ex_addr(F, t, src, dst);
    LAS unsigned char* ts = F.lds;
    const int nq = F.tid & 31, kg = F.tid >> 5;
    __builtin_amdgcn_s_barrier();
#pragma unroll
    for (int c = 0; c < 4; ++c) { u32x4 w; w.x = cvt_pk_bf16(v[0][c], v[1][c]); w.y = cvt_pk_bf16(v[2][c], v[3][c]); w.z = cvt_pk_bf16(v[4][c], v[5][c]); w.w = cvt_pk_bf16(v[6][c], v[7][c]);
        *(LAS u32x4*)(ts + (nq * 4 + c) * CV_LDB + kg * 16) = w; }
    asm volatile("s_waitcnt lgkmcnt(0)" ::: "memory"); __builtin_amdgcn_s_barrier();
#pragma unroll
    for (int it = 0; it < 4; ++it) { const int slot = it * NT + F.tid, kq = slot & 15, n = slot >> 4;
        const u32x4 w = *(LAS u32x4*)(ts + n * CV_LDB + kq * 16);
        *(u32x4*)(dst + (size_t)n * 1024 + kq * 8) = w; }
}
template <bool PRE = false> __device__ __forceinline__ void p_cvt_experts(const Frame& F, int e_lo, int e_hi, int bid, int G, f4 (&va)[8]) {
    const int tend = e_hi * 128;
    int t = e_lo * 128 + bid;
    if (t >= tend) return;
    f4 vb[8];
    if (!PRE) cvt_ex_load(F, t, va);
    for (;;) {
        if (t + G < tend) cvt_ex_load(F, t + G, vb);
        cvt_ex_store(F, t, va); t += G; if (t >= tend) break;
        if (t + G < tend) cvt_ex_load(F, t + G, va);
        cvt_ex_store(F, t, vb); t += G; if (t >= tend) break;
    }
}
__device__ __forceinline__ void p_cvt_experts(const Frame& F, int e_lo, int e_hi, int bid, int G) { f4 va[8]; p_cvt_experts<false>(F, e_lo, e_hi, bid, G, va); }

__device__ __forceinline__ void p_mod(const Frame& F) {
    const float* c = F.in[1]; const float* cc = F.in[3]; const float* w = F.in[4]; const float* b = F.in[5];
    float* mod = (float*)(F.ws + WS_MOD);
    LAS float* sc = F.sm;
    LAS float* red = F.sm + 5 * 1024;
    if (F.bid < 192) {
        for (int i = F.tid; i < 5 * 1024; i += NT) { const int r = i >> 10, k = i & 1023; const float x = r < 4 ? c[r * D + k] : cc[k]; sc[i] = x * sigmoid_acc(x); }
    }
    for (int u = F.bid; u < 192; u += F.G) {
        __syncthreads();
        const int part = F.wave * 2 + (F.lane >> 5), cl = F.lane & 31, col = u * 32 + cl, k0 = part * 64;
        float a0 = 0.f, a1 = 0.f, a2 = 0.f, a3 = 0.f, a4 = 0.f;
#pragma unroll 32
        for (int k = 0; k < 64; ++k) { const float wv = w[(size_t)(k0 + k) * 6144 + col];
            a0 = fmaf(sc[k0 + k], wv, a0); a1 = fmaf(sc[1024 + k0 + k], wv, a1); a2 = fmaf(sc[2048 + k0 + k], wv, a2); a3 = fmaf(sc[3072 + k0 + k], wv, a3); a4 = fmaf(sc[4096 + k0 + k], wv, a4); }
        red[(part * 5 + 0) * 32 + cl] = a0; red[(part * 5 + 1) * 32 + cl] = a1; red[(part * 5 + 2) * 32 + cl] = a2; red[(part * 5 + 3) * 32 + cl] = a3; red[(part * 5 + 4) * 32 + cl] = a4;
        __syncthreads();
        if (F.tid < 160) { const int r = F.tid >> 5, c2 = F.tid & 31; float t = b[u * 32 + c2];
#pragma unroll
            for (int pt = 0; pt < 16; ++pt) t += red[(pt * 5 + r) * 32 + c2];
            mod[r * 6144 + u * 32 + c2] = t; }
    }
}
__device__ __forceinline__ void p_mod_cvt_small(const Frame& F) {
    f4 va[8], vb[8];
    const int t0 = F.bid, t1 = F.bid + F.G;
    if (t0 < CVS_TILES) cvs_load(F, t0, va);
    const int ridx = F.bid * NT + F.tid; float rwv = 0.f;
    if (ridx < 32 * 1024) rwv = F.in[27][(ridx & 1023) * NE + (ridx >> 10)];
    p_mod(F);
    if (ridx < 32 * 1024) { bf16_t* hi = (bf16_t*)(F.ws + WS_WRT); bf16_t* lo = hi + 32 * 1024;
        const unsigned w = cvt_pk_bf16(rwv, 0.f); hi[ridx] = (bf16_t)(w & 0xffffu); lo[ridx] = f2bf(rwv - bf_lo(w)); }
    if (t1 < CVS_TILES) cvs_load(F, t1, vb);
    if (t0 < CVS_TILES) cvs_store(F, t0, va);
    if (t1 < CVS_TILES) cvs_store(F, t1, vb);
    for (int t = F.bid + 2 * F.G; t < CVS_TILES; t += F.G) { cvs_load(F, t, va); cvs_store(F, t, va); }
}
__device__ __forceinline__ void p_norm1(const Frame& F, bf16_t* dst, int row_lo, int row_hi, int bid, int G) {
    const float* mod = (const float*)(F.ws + WS_MOD); const float* g = F.in[6];
    for (int row = row_lo + bid * 8 + F.wave; row < row_hi; row += G * 8) {
        const float* src; int r;
        if (row < NTOK) { src = F.in[0] + (size_t)row * D; r = row / SEQ; } else { src = F.in[2] + (size_t)(row - NTOK) * D; r = 4; }
        f4 v[4]; float ss = 0.f;
#pragma unroll
        for (int i = 0; i < 4; ++i) { v[i] = *(const f4*)(src + i * 256 + F.lane * 4); ss += v[i].x * v[i].x + v[i].y * v[i].y + v[i].z * v[i].z + v[i].w * v[i].w; }
        ss = wave_sum(ss);
        const float rs = rsqrtf(ss * (1.0f / D) + 1e-6f);
#pragma unroll
        for (int i = 0; i < 4; ++i) {
            const int cidx = i * 256 + F.lane * 4;
            const f4 gg = *(const f4*)(g + cidx), sh = *(const f4*)(mod + r * 6144 + cidx), sc = *(const f4*)(mod + r * 6144 + 1024 + cidx);
            u32x2 o; o.x = cvt_pk_bf16(v[i].x * rs * gg.x * (1.f + sc.x) + sh.x, v[i].y * rs * gg.y * (1.f + sc.y) + sh.y);
            o.y = cvt_pk_bf16(v[i].z * rs * gg.z * (1.f + sc.z) + sh.z, v[i].w * rs * gg.w * (1.f + sc.w) + sh.w);
            *(u32x2*)(dst + (size_t)row * D + cidx) = o;
        }
    }
}
__device__ __forceinline__ void p_cvt_lora(const Frame& F) {
    bf16_t* T = (bf16_t*)(F.ws + WS_LORAT);
    for (int idx = F.bid * NT + F.tid; idx < 2560 * 384; idx += F.G * NT) {
        const int n = idx / 384, kc = idx % 384, seg = n >> 9, ch = n & 511; float v = 0.f;
        if (seg < 2) { if ((kc >> 6) == seg) v = F.in[10][((size_t)seg * 64 + (kc & 63)) * RW + ch]; }
        else if (seg < 4) { if ((kc >> 6) == seg) v = F.in[12][((size_t)(seg - 2) * 64 + (kc & 63)) * RW + ch]; }
        else { if (kc >= 256) v = F.in[13][(size_t)(kc - 256) * RW + ch]; }
        T[idx] = f2bf(v);
    }
}
__device__ __forceinline__ void p_prepA(const Frame& F, const bf16_t* P, bf16_t* R, bf16_t* Kraw, bf16_t* V, bf16_t* A, bf16_t* Alora) {
    const float* mu = F.in[8]; const float* k_k = F.in[14];
    f4 mu0[4], mu1[4];
#pragma unroll
    for (int seg = 0; seg < 4; ++seg) { const int c0 = seg * 512 + F.lane * 8; const bool in = seg < 3 || F.lane < 48;
        mu0[seg] = in ? *(const f4*)(mu + c0) : (f4){0.f, 0.f, 0.f, 0.f}; mu1[seg] = in ? *(const f4*)(mu + c0 + 4) : (f4){0.f, 0.f, 0.f, 0.f}; }
    const f4 kk0 = *(const f4*)(k_k + F.lane * 8), kk1 = *(const f4*)(k_k + F.lane * 8 + 4);
    for (int it = 0;; ++it) {
        int row = F.bid * 8 + F.wave + it * F.G * 8;
        if (F.G == 256 && it == 8) row = F.wave < 4 ? NTOK + F.wave * 256 + F.bid : NROW;
        if (row >= NROW) break;
        const bf16_t* own = P + (size_t)row * PRW_LD;
        const bf16_t* nb[4]; bool ok[4];
        if (row < NTOK) { const int t = row % SEQ, gy = t >> 6, gx = t & 63;
            nb[0] = own - PRW_LD; ok[0] = gx > 0; nb[1] = own + PRW_LD; ok[1] = gx < 63; nb[2] = own - 64 * PRW_LD; ok[2] = gy > 0; nb[3] = own + 64 * PRW_LD; ok[3] = gy < 63;
        } else { const int t = (row - NTOK) % CTXL;
            nb[0] = own - PRW_LD; ok[0] = t > 0; nb[1] = own + PRW_LD; ok[1] = t < CTXL - 1; nb[2] = nb[0]; ok[2] = ok[0]; nb[3] = nb[1]; ok[3] = ok[1]; }
#pragma unroll
        for (int q = 0; q < 4; ++q) nb[q] = ok[q] ? nb[q] : own;
        u32x4 pwa[4], nwa[4][4];
#pragma unroll
        for (int seg = 0; seg < 4; ++seg) { const int c0 = seg * 512 + F.lane * 8;
            pwa[seg] = *(const u32x4*)(own + c0);
#pragma unroll
            for (int q = 0; q < 4; ++q) nwa[seg][q] = *(const u32x4*)(nb[q] + c0); }
#pragma unroll
        for (int seg = 0; seg < 4; ++seg) {
            if (seg == 3 && F.lane >= 48) break;
            const int c0 = seg * 512 + F.lane * 8;
            const u32x4 pw = pwa[seg];
            u32x4 nw[4];
#pragma unroll
            for (int q = 0; q < 4; ++q) { const unsigned mk = ok[q] ? 0xffffffffu : 0u; nw[q] = nwa[seg][q]; nw[q].x &= mk; nw[q].y &= mk; nw[q].z &= mk; nw[q].w &= mk; }
            const f4 m0 = mu0[seg], m1 = mu1[seg];
            const float p[8] = {bf_lo(pw.x), bf_hi(pw.x), bf_lo(pw.y), bf_hi(pw.y), bf_lo(pw.z), bf_hi(pw.z), bf_lo(pw.w), bf_hi(pw.w)};
            const float sv[8] = {bf_lo(nw[0].x), bf_hi(nw[1].x), bf_lo(nw[2].y), bf_hi(nw[3].y), bf_lo(nw[0].z), bf_hi(nw[1].z), bf_lo(nw[2].w), bf_hi(nw[3].w)};
            const float mv[8] = {m0.x, m0.y, m0.z, m0.w, m1.x, m1.y, m1.z, m1.w};
            float o[8];
#pragma unroll
            for (int j = 0; j < 8; ++j) o[j] = p[j] + mv[j] * (sv[j] - p[j]);
            const size_t ro = (size_t)row * RW + F.lane * 8;
#define PK8(x_) (u32x4){cvt_pk_bf16(x_[0], x_[1]), cvt_pk_bf16(x_[2], x_[3]), cvt_pk_bf16(x_[4], x_[5]), cvt_pk_bf16(x_[6], x_[7])}
            if (seg == 0) { *(u32x4*)(R + ro) = PK8(o); }
            else if (seg == 2) { *(u32x4*)(V + ro) = PK8(o); }
            else if (seg == 1) {
                *(u32x4*)(Kraw + ro) = PK8(o);
                const f4 q0 = kk0, q1 = kk1;
                float x[8] = {o[0] * q0.x, o[1] * q0.y, o[2] * q0.z, o[3] * q0.w, o[4] * q1.x, o[5] * q1.y, o[6] * q1.z, o[7] * q1.w};
                float ss = 0.f;
#pragma unroll
                for (int j = 0; j < 8; ++j) ss += x[j] * x[j];
                const float rn = -rsqrtf(sum8(ss) + 1e-12f);
#pragma unroll
                for (int j = 0; j < 8; ++j) x[j] *= rn;
                *(u32x4*)(A + ro) = PK8(x);
            } else {
                { const float ab = F.lane < 16 ? 2.0f : 1.0f, cc = F.lane < 16 ? -1.0f : 0.0f; const bool idn = (F.lane >> 4) == 1;
#pragma unroll
                  for (int j = 0; j < 8; ++j) { const float sg = ab * sigmoid_fast(ab * o[j]) + cc; o[j] = idn ? o[j] : sg; } }
                u32x4 w; w.x = cvt_pk_bf16(o[0], o[1]); w.y = cvt_pk_bf16(o[2], o[3]); w.z = cvt_pk_bf16(o[4], o[5]); w.w = cvt_pk_bf16(o[6], o[7]);
                *(u32x4*)(Alora + (size_t)row * 384 + F.lane * 8) = w;
            }
        }
    }
}
constexpr int CQ_PITCH = 144, CQ_BYTES = 64 * CQ_PITCH, CQ_PER_WAVE = 24;
__device__ __forceinline__ void cq_decode(const Frame& F, int g, const float*& src, bf16_t*& dst) {
    const int m = g >> 8, e = m / 3, which = m - e * 3, kt = (g >> 4) & 15, nt = g & 15;
    src = (which == 0 ? F.in[29] : which == 1 ? F.in[31] : F.in[33]) + (size_t)e * D * D + (size_t)kt * 64 * D + nt * 64;
    dst = which == 2 ? (bf16_t*)F.out + ((size_t)e * 1024 + nt * 64) * 1024 + kt * 64
                     : (bf16_t*)(F.ws + WS_W1T) + ((size_t)e * 2048 + (nt >> 1) * 256 + (which == 1 ? 128 : 0) + (nt & 1) * 64) * 1024 + kt * 64;
}
__device__ __forceinline__ void cq_load(const Frame& F, int g, f4 (&cv)[16]) {
    const float* src; bf16_t* dst; cq_decode(F, g, src, dst);
    const int kb = F.lane >> 4, c4 = (F.lane & 15) * 4;
#pragma unroll
    for (int i = 0; i < 16; ++i) cv[i] = *(const f4*)(src + (size_t)(kb * 16 + i) * D + c4);
}
__device__ __forceinline__ void cq_write(const Frame& F, int g, const f4 (&cv)[16], LAS unsigned char* t) {
    const float* src; bf16_t* dst; cq_decode(F, g, src, dst);
    const int kb = F.lane >> 4, c4 = (F.lane & 15) * 4;
#pragma unroll
    for (int c = 0; c < 4; ++c) { u32x4 w0, w1;
        w0.x = cvt_pk_bf16(cv[0][c], cv[1][c]); w0.y = cvt_pk_bf16(cv[2][c], cv[3][c]); w0.z = cvt_pk_bf16(cv[4][c], cv[5][c]); w0.w = cvt_pk_bf16(cv[6][c], cv[7][c]);
        w1.x = cvt_pk_bf16(cv[8][c], cv[9][c]); w1.y = cvt_pk_bf16(cv[10][c], cv[11][c]); w1.z = cvt_pk_bf16(cv[12][c], cv[13][c]); w1.w = cvt_pk_bf16(cv[14][c], cv[15][c]);
        *(LAS u32x4*)(t + (c4 + c) * CQ_PITCH + kb * 32) = w0; *(LAS u32x4*)(t + (c4 + c) * CQ_PITCH + kb * 32 + 16) = w1; }
    __builtin_amdgcn_wave_barrier(); asm volatile("s_waitcnt lgkmcnt(0)" ::: "memory");
    const int k8 = F.lane & 7, n0 = F.lane >> 3;
#pragma unroll
    for (int j = 0; j < 8; ++j) { const int n = n0 + 8 * j; const u32x4 w = *(LAS u32x4*)(t + n * CQ_PITCH + k8 * 16); *(u32x4*)(dst + (size_t)n * 1024 + k8 * 8) = w; }
    __builtin_amdgcn_wave_barrier();
}
constexpr int SC_TB = 32, SC_STEPS = CTXL + SEQ, SC_NBLK = SC_STEPS / SC_TB;
constexpr int SC_BUF = 5 * SC_TB * 64 + SC_TB * 16 + SC_TB * 2;
__device__ __forceinline__ int scan_blk_row(int b, int dir, int blk) {
    const int p0 = blk * SC_TB;
    if (p0 < CTXL) return NTOK + b * CTXL + (dir ? (CTXL - 1 - p0) : p0);
    const int q = p0 - CTXL; return b * SEQ + (dir ? (SEQ - 1 - q) : q);
}
struct ScanRegs { u32x4 q[5]; u32x4 v; };
__device__ __forceinline__ void unpack8(const u32x4 w, float (&o)[8]) { o[0] = bf_lo(w.x); o[1] = bf_hi(w.x); o[2] = bf_lo(w.y); o[3] = bf_hi(w.y); o[4] = bf_lo(w.z); o[5] = bf_hi(w.z); o[6] = bf_lo(w.w); o[7] = bf_hi(w.w); }
template <int MODE> __device__ __forceinline__ void p_scan(const Frame& F, const bf16_t* R, const bf16_t* A, const bf16_t* V, const bf16_t* LW, const bf16_t* KD, const bf16_t* Bd, bf16_t* Y) {
    for (int u = F.bid; u < NB * NH * 2 * 4; u += F.G) {
        int vs, dir, h, b;
        if (F.G == 256) { vs = (u >> 3) & 3; const int ch = (u & 7) | ((u >> 5) << 3); dir = ch & 1; h = (ch >> 1) & 7; b = ch >> 4; }
        else { vs = u & 3; dir = (u >> 2) & 1; h = (u >> 3) & 7; b = u >> 6; }
        const size_t dofs = (size_t)dir * NROW * RW;
        const bf16_t* arr[5] = {R, LW + dofs, KD + dofs, A, Bd + dofs};
        bf16_t* Yd = Y + (size_t)dir * NTOK * RW;
        const bool comp = F.tid < 256;
        const int lt = F.tid & 255, sgn = dir ? -1 : 1;
        const int vl = lt >> 4, kq = lt & 15;
        const int l_st = lt >> 3, l_oct = lt & 7, l_off = sgn * l_st * RW + h * 64 + l_oct * 8, l_lds = l_st * 64 + l_oct * 8;
        const int v_st = (lt & 63) >> 1, v_hf = lt & 1, v_off = sgn * v_st * RW + h * 64 + vs * 16 + v_hf * 8;
        float S0 = 0.f, S1 = 0.f, S2 = 0.f, S3 = 0.f, yk = 0.f;
        ScanRegs qs[2];
        f4 cv[16];
        const bool do_cvt = (MODE == 0) && (F.G == 256) && (u == F.bid);
        LAS unsigned char* cq_t = F.lds + 2 * SC_BUF * 4 + ((F.wave - 4) & 3) * CQ_BYTES;
#define SC_LOAD(blk_, QS_) do { const size_t rb_ = (size_t)scan_blk_row(b, dir, (blk_)) * RW; _Pragma("unroll") for (int i = 0; i < 5; ++i) QS_.q[i] = *(const u32x4*)(arr[i] + rb_ + l_off); \
            if (lt < 64) QS_.v = *(const u32x4*)(V + rb_ + v_off); } while (0)
#define SC_ST8(buf_, off_, x_) do { *(LAS f4*)&(buf_)[(off_)] = (f4){x_[0], x_[1], x_[2], x_[3]}; *(LAS f4*)&(buf_)[(off_) + 4] = (f4){x_[4], x_[5], x_[6], x_[7]}; } while (0)
#define SC_STORE(buf_, QS_) do { float r_[8], w_[8], k_[8], a_[8], b_[8]; unpack8(QS_.q[0], r_); unpack8(QS_.q[1], w_); unpack8(QS_.q[2], k_); unpack8(QS_.q[3], a_); unpack8(QS_.q[4], b_); \
            float br_ = 0.f, kr_ = 0.f; _Pragma("unroll") for (int j = 0; j < 8; ++j) { w_[j] = __expf(w_[j]); br_ = fmaf(b_[j], r_[j], br_); kr_ = fmaf(k_[j], r_[j], kr_); r_[j] *= w_[j]; } \
            br_ = sum8(br_); kr_ = sum8(kr_); \
            SC_ST8(buf_, 0 * SC_TB * 64 + l_lds, r_); SC_ST8(buf_, 1 * SC_TB * 64 + l_lds, w_); SC_ST8(buf_, 2 * SC_TB * 64 + l_lds, k_); SC_ST8(buf_, 3 * SC_TB * 64 + l_lds, a_); SC_ST8(buf_, 4 * SC_TB * 64 + l_lds, b_); \
            if (l_oct == 0) { (buf_)[5 * SC_TB * 64 + SC_TB * 16 + l_st * 2] = br_; (buf_)[5 * SC_TB * 64 + SC_TB * 16 + l_st * 2 + 1] = kr_; } \
            if (lt < 64) { float v_[8]; unpack8(QS_.v, v_); SC_ST8(buf_, 5 * SC_TB * 64 + v_st * 16 + v_hf * 8, v_); } } while (0)
        __syncthreads();
        if (!comp) { SC_LOAD(0, qs[0]); SC_LOAD(1, qs[1]); SC_STORE(F.sm, qs[0]); SC_LOAD(2, qs[0]); }
        __syncthreads();
        for (int blk0 = 0; blk0 < SC_NBLK; blk0 += 2) {
#pragma unroll
          for (int j3 = 0; j3 < 2; ++j3) {
            const int blk = blk0 + j3;
            if (blk < SC_NBLK) {
            LAS float* cur = F.sm + (blk & 1) * SC_BUF;
            if (!comp) {
                LAS float* nb = F.sm + ((blk + 1) & 1) * SC_BUF;
                if (blk + 1 < SC_NBLK) SC_STORE(nb, qs[(j3 + 1) % 2]);
                if (blk + 3 < SC_NBLK) SC_LOAD(blk + 3, qs[(j3 + 1) % 2]);
                if (do_cvt) { const int jq = blk / 5, ph = blk - jq * 5;
                    if (jq < CQ_PER_WAVE) { const int g = jq * 1024 + F.bid * 4 + (F.wave - 4);
                        if (ph == 3) cq_write(F, g, cv, cq_t);
                        if (ph == 1) cq_load(F, g, cv); } }
            } else {
                const bool emit = blk * SC_TB >= CTXL;
                const int rowb = scan_blk_row(b, dir, blk);
                typedef float f2 __attribute__((ext_vector_type(2)));
#define SC_RD(st_, R01, R23, W01, W23, K01, K23, A01, A23, B01, B23, VV, BR, KR) do { \
                    const f4 r_ = *(LAS f4*)&cur[0 * SC_TB * 64 + (st_) * 64 + kq * 4], w_ = *(LAS f4*)&cur[1 * SC_TB * 64 + (st_) * 64 + kq * 4], k_ = *(LAS f4*)&cur[2 * SC_TB * 64 + (st_) * 64 + kq * 4], \
                             a_ = *(LAS f4*)&cur[3 * SC_TB * 64 + (st_) * 64 + kq * 4], b_ = *(LAS f4*)&cur[4 * SC_TB * 64 + (st_) * 64 + kq * 4]; \
                    R01 = (f2){r_.x, r_.y}; R23 = (f2){r_.z, r_.w}; W01 = (f2){w_.x, w_.y}; W23 = (f2){w_.z, w_.w}; K01 = (f2){k_.x, k_.y}; K23 = (f2){k_.z, k_.w}; \
                    A01 = (f2){a_.x, a_.y}; A23 = (f2){a_.z, a_.w}; B01 = (f2){b_.x, b_.y}; B23 = (f2){b_.z, b_.w}; VV = cur[5 * SC_TB * 64 + (st_) * 16 + vl]; \
                    const f2 sc_ = *(LAS f2*)&cur[5 * SC_TB * 64 + SC_TB * 16 + (st_) * 2]; BR = sc_.x; KR = sc_.y; } while (0)
                f2 S01 = (f2){S0, S1}, S23 = (f2){S2, S3};
                f2 nR01, nR23, nW01, nW23, nK01, nK23, nA01, nA23, nB01, nB23; float nV, nBR, nKR;
                SC_RD(0, nR01, nR23, nW01, nW23, nK01, nK23, nA01, nA23, nB01, nB23, nV, nBR, nKR);
#pragma unroll 1
                for (int half = 0; half < 2; ++half) {
#pragma unroll 4
                    for (int s16 = 0; s16 < 16; ++s16) {
                        const int st = half * 16 + s16;
                        const f2 R01 = nR01, R23 = nR23, W01 = nW01, W23 = nW23, K01 = nK01, K23 = nK23, A01 = nA01, A23 = nA23, B01 = nB01, B23 = nB23; const float vv = nV, brs = nBR, krs = nKR;
                        { const int sn = (st + 1) & (SC_TB - 1); SC_RD(sn, nR01, nR23, nW01, nW23, nK01, nK23, nA01, nA23, nB01, nB23, nV, nBR, nKR); }
                        const f2 sa2 = S01 * A01 + S23 * A23, yp2 = S01 * R01 + S23 * R23;
                        float sa = sa2.x + sa2.y, yp = yp2.x + yp2.y;
                        sa += dpp_f<0xB1>(sa); yp += dpp_f<0xB1>(yp); sa += dpp_f<0x4E>(sa); yp += dpp_f<0x4E>(yp);
                        sa += dpp_f<0x141>(sa); yp += dpp_f<0x141>(yp); sa += dpp_f<0x140>(sa); yp += dpp_f<0x140>(yp);
                        S01 = S01 * W01 + (B01 * sa + K01 * vv); S23 = S23 * W23 + (B23 * sa + K23 * vv);
                        const float y = fmaf(sa, brs, fmaf(vv, krs, yp));
                        yk = (kq == s16) ? y : yk;
                    }
                    if (emit) { const int row = rowb + sgn * (half * 16 + kq); Yd[(size_t)row * RW + h * 64 + vs * 16 + vl] = f2bf(yk); }
                }
                S0 = S01.x; S1 = S01.y; S2 = S23.x; S3 = S23.y;
#undef SC_RD
            }
            }
            __syncthreads();
          }
        }
#undef SC_LOAD
#undef SC_STORE
#undef SC_ST8
    }
}

typedef short bf16x4_t __attribute__((ext_vector_type(4)));
typedef float f32x4_t __attribute__((ext_vector_type(4)));
constexpr int CK_C = 16, CK_NCH = (CTXL + SEQ) / CK_C, CK_BYTES = 9472, CK_TASKS = NB * NH * 2 * CK_NCH;
constexpr size_t WS_FRAG = 288 * MiB;
static_assert(WS_FRAG + (size_t)CK_TASKS * CK_BYTES <= 512 * MiB, "fragment region");
static_assert(WS_FRAG + (size_t)CK_TASKS * CK_BYTES + 1024 <= WS_W1T + 16 * 4 * MiB, "W1t of experts >= 16 is written while the fragments are live");
__device__ __forceinline__ bf16x4_t pk4(const f32x4_t x) { u32x2 w; w.x = cvt_pk_bf16(x[0], x[1]); w.y = cvt_pk_bf16(x[2], x[3]); return __builtin_bit_cast(bf16x4_t, w); }
__device__ __forceinline__ bf16x8_t pk8(const f32x4_t lo, const f32x4_t hi) { u32x4 w; w.x = cvt_pk_bf16(lo[0], lo[1]); w.y = cvt_pk_bf16(lo[2], lo[3]); w.z = cvt_pk_bf16(hi[0], hi[1]); w.w = cvt_pk_bf16(hi[2], hi[3]); return __builtin_bit_cast(bf16x8_t, w); }
__device__ __forceinline__ bf16x8_t pk8a(const float* x) { u32x4 w; w.x = cvt_pk_bf16(x[0], x[1]); w.y = cvt_pk_bf16(x[2], x[3]); w.z = cvt_pk_bf16(x[4], x[5]); w.w = cvt_pk_bf16(x[6], x[7]); return __builtin_bit_cast(bf16x8_t, w); }
__device__ __forceinline__ f32x4_t mf32n_(bf16x8_t a, bf16x8_t b, f32x4_t c) { f32x4_t d = __builtin_amdgcn_mfma_f32_16x16x32_bf16(a, b, c, 0, 0, 0); asm volatile("s_nop 7" : "+v"(d)); return d; }
__device__ __forceinline__ f32x4_t mf16n_(bf16x4_t a, bf16x4_t b, f32x4_t c) { f32x4_t d = __builtin_amdgcn_mfma_f32_16x16x16bf16_1k(a, b, c, 0, 0, 0); asm volatile("s_nop 7" : "+v"(d)); return d; }
#define MF32N(a_, b_, c_) mf32n_((a_), (b_), (c_))
#define MF16N(a_, b_, c_) mf16n_((a_), (b_), (c_))
#define MF32(a_, b_, c_) __builtin_amdgcn_mfma_f32_16x16x32_bf16((a_), (b_), (c_), 0, 0, 0)
#define MF16(a_, b_, c_) __builtin_amdgcn_mfma_f32_16x16x16bf16_1k((a_), (b_), (c_), 0, 0, 0)
__device__ __forceinline__ int ck_row(int b, int dir, int p) {
    if (p < CTXL) return NTOK + b * CTXL + (dir ? (CTXL - 1 - p) : p);
    const int q = p - CTXL; return b * SEQ + (dir ? (SEQ - 1 - q) : q);
}
__device__ __forceinline__ void p_chunk_pre(const Frame& F, const bf16_t* R, const bf16_t* A, const bf16_t* LW, const bf16_t* KD, const bf16_t* Bd) {
    const int n = F.lane & 15, g = F.lane >> 4;
    const f32x4_t Z4 = {0.f, 0.f, 0.f, 0.f};
    bf16x8_t bid[2];
    { const int d = n - 4 * g;
#pragma unroll
      for (int hb = 0; hb < 2; ++hb) { u32x4 w = {0u, 0u, 0u, 0u}; if (d >= 0 && d < 4) { const int j = 4 * hb + d; const unsigned one = (j & 1) ? 0x3F800000u : 0x00003F80u; const int wi = j >> 1;
            w.x = wi == 0 ? one : 0u; w.y = wi == 1 ? one : 0u; w.z = wi == 2 ? one : 0u; w.w = wi == 3 ? one : 0u; } bid[hb] = __builtin_bit_cast(bf16x8_t, w); } }
    f32x4_t Idm, mLow, mUp, mUpE;
#pragma unroll
    for (int i = 0; i < 4; ++i) { const int row = 4 * g + i; Idm[i] = row == n ? 1.f : 0.f; mLow[i] = n < row ? 1.f : 0.f; mUp[i] = row < n ? 1.f : 0.f; mUpE[i] = row <= n ? 1.f : 0.f; }
    u32x4 nLW[2], nA[2], nB[2], nK[2], nR[2];
#define CK_IN(task_) do { const int ch_ = (task_) / CK_NCH, c_ = (task_) - ch_ * CK_NCH, dir_ = ch_ & 1; \
        const size_t ro_ = (size_t)ck_row(ch_ >> 4, dir_, c_ * CK_C + n) * RW + ((ch_ >> 1) & 7) * 64 + 16 * g, do_ = (size_t)dir_ * NROW * RW; \
        _Pragma("unroll") for (int t_ = 0; t_ < 2; ++t_) { nLW[t_] = *(const u32x4*)(LW + do_ + ro_ + 8 * t_); nA[t_] = *(const u32x4*)(A + ro_ + 8 * t_); nB[t_] = *(const u32x4*)(Bd + do_ + ro_ + 8 * t_); \
            nK[t_] = *(const u32x4*)(KD + do_ + ro_ + 8 * t_); nR[t_] = *(const u32x4*)(R + ro_ + 8 * t_); } } while (0)
    { const int t0 = F.wave * F.G + F.bid; if (t0 < CK_TASKS) CK_IN(t0); }
    for (int task = F.wave * F.G + F.bid; task < CK_TASKS; task += F.G * 8) {
        float at[16], rt[16], bh[16], kh[16], bc[16], kc[16], gam[16];
        {
            float lwv[16], Lc[16], av[16], bv[16], kv[16], rv[16];
#pragma unroll
            for (int t2 = 0; t2 < 2; ++t2) { unpack8(nLW[t2], *(float(*)[8])(lwv + 8 * t2)); unpack8(nA[t2], *(float(*)[8])(av + 8 * t2)); unpack8(nB[t2], *(float(*)[8])(bv + 8 * t2));
                unpack8(nK[t2], *(float(*)[8])(kv + 8 * t2)); unpack8(nR[t2], *(float(*)[8])(rv + 8 * t2)); }
            { const int tn = task + F.G * 8; if (tn < CK_TASKS) CK_IN(tn); }
#pragma unroll
            for (int e = 0; e < 16; ++e) { float x = lwv[e]; x += dpp_f<0x111>(x); x += dpp_f<0x112>(x); x += dpp_f<0x114>(x); x += dpp_f<0x118>(x); Lc[e] = x;
                gam[e] = __expf(dpp_f<0x15F>(x)); }
#pragma unroll
            for (int e = 0; e < 16; ++e) { const float eL = __expf(Lc[e]), ie = __builtin_amdgcn_rcpf(eL);
                const float eXs = dpp_f<0x111>(eL), eX = n == 0 ? 1.0f : eXs;
                at[e] = av[e] * eX; rt[e] = rv[e] * eL; bh[e] = -(av[e] * bv[e]) * ie;     kh[e] = kv[e] * ie; bc[e] = bh[e] * gam[e]; kc[e] = kh[e] * gam[e]; }
        }
        const bf16x8_t atF0 = pk8a(at), atF1 = pk8a(at + 8), rtF0 = pk8a(rt), rtF1 = pk8a(rt + 8), bhF0 = pk8a(bh), bhF1 = pk8a(bh + 8), khF0 = pk8a(kh), khF1 = pk8a(kh + 8);
        const bf16x8_t bcF0 = pk8a(bc), bcF1 = pk8a(bc + 8), kcF0 = pk8a(kc), kcF1 = pk8a(kc + 8);
        const f32x4_t Ld = MF32N(atF1, bhF1, MF32(atF0, bhF0, Z4)) * mLow;
        const f32x4_t LTd = MF32N(bhF1, atF1, MF32(bhF0, atF0, Z4)) * mUp;
        const f32x4_t Nd = MF32N(atF1, khF1, MF32(atF0, khF0, Z4)) * mLow;
        const f32x4_t QTd = MF32N(bhF1, rtF1, MF32(bhF0, rtF0, Z4)) * mUpE;
        const f32x4_t ZTd = MF32N(khF1, rtF1, MF32(khF0, rtF0, Z4)) * mUpE;
#define CK_PROD(xt_, y_) MF16N(pk4(xt_), pk4(y_), Z4)
        f32x4_t TT;
        { const f32x4_t P2 = CK_PROD(Ld, LTd), P2T = CK_PROD(LTd, Ld);
          const f32x4_t X1 = Idm + LTd, X1T = Idm + Ld;
          const f32x4_t X2 = X1 + CK_PROD(X1T, P2), X2T = X1T + CK_PROD(P2, X1T);
          const f32x4_t P4 = CK_PROD(P2T, P2), P4T = CK_PROD(P2, P2T);
          const f32x4_t X3 = X2 + CK_PROD(X2T, P4), X3T = X2T + CK_PROD(P4, X2T);
          const f32x4_t P8 = CK_PROD(P4T, P4);
          TT = X3 + CK_PROD(X3T, P8); }
        const bf16x4_t TTp = pk4(TT), QTp = pk4(QTd), Ndp = pk4(Nd);
        f32x4_t Mv = MF16(TTp, Ndp, Z4), MvT = MF16(Ndp, TTp, Z4);
        asm volatile("s_nop 7" : "+v"(Mv), "+v"(MvT));
        const bf16x4_t Mvp = pk4(Mv);
        unsigned char* outp = F.ws + WS_FRAG + (size_t)task * CK_BYTES;
        f32x4_t RpT[4], ApT[4];
#pragma unroll
        for (int tau = 0; tau < 4; ++tau) {
            f32x4_t atK = MF32(tau < 2 ? atF0 : atF1, bid[tau & 1], Z4);
            asm volatile("s_nop 7" : "+v"(atK));
            const bf16x4_t atKp = pk4(atK);
            f32x4_t Ap = MF16(TTp, atKp, Z4); ApT[tau] = MF16(atKp, TTp, Z4);
            asm volatile("s_nop 7" : "+v"(Ap), "+v"(ApT[tau]));
            const f32x4_t r0 = {rt[4 * tau], rt[4 * tau + 1], rt[4 * tau + 2], rt[4 * tau + 3]};
            RpT[tau] = MF16N(pk4(Ap), QTp, r0);
        }
        *(bf16x8_t*)(outp + 0 * 1024 + F.lane * 16) = pk8(RpT[0], RpT[1]);
        *(bf16x8_t*)(outp + 1 * 1024 + F.lane * 16) = pk8(RpT[2], RpT[3]);
        *(bf16x8_t*)(outp + 2 * 1024 + F.lane * 16) = pk8(ApT[0], ApT[1]);
        *(bf16x8_t*)(outp + 3 * 1024 + F.lane * 16) = pk8(ApT[2], ApT[3]);
        *(bf16x4_t*)(outp + 4096 + 0 * 512 + F.lane * 8) = pk4(MF16N(Mvp, QTp, ZTd));
        *(bf16x4_t*)(outp + 4096 + 1 * 512 + F.lane * 8) = pk4(MvT);
#pragma unroll
        for (int tp = 0; tp < 4; ++tp) {
            f32x4_t bcK = MF32(tp < 2 ? bcF0 : bcF1, bid[tp & 1], Z4), kcK = MF32(tp < 2 ? kcF0 : kcF1, bid[tp & 1], Z4);
            asm volatile("s_nop 7" : "+v"(bcK), "+v"(kcK));
            *(bf16x4_t*)(outp + 4096 + (2 + tp) * 512 + F.lane * 8) = pk4(bcK);
            *(bf16x4_t*)(outp + 4096 + (6 + tp) * 512 + F.lane * 8) = pk4(kcK);
        }
        if (n == 0) {
#pragma unroll
            for (int e4 = 0; e4 < 4; ++e4) *(f4*)(outp + 9216 + g * 64 + e4 * 16) = (f4){gam[4 * e4], gam[4 * e4 + 1], gam[4 * e4 + 2], gam[4 * e4 + 3]}; }
#undef CK_PROD
    }
#undef CK_IN
}
constexpr int CKR_SLOTS = 8, CKR_VOFF = 10240, CKR_SLOT = 12288, CKR_AHEAD = CKR_SLOTS - 1;
__device__ __forceinline__ void cs_tile(const Frame& F, int j, int ktb, int nt, const float*& src, bf16_t*& dst) {
    const int k0 = (ktb + 8 * (j & 1)) * 64, n0 = nt * 32;
    if (j < 64) { const int e = j >> 1; src = F.in[33] + (size_t)e * D * D + (size_t)k0 * D + n0; dst = (bf16_t*)F.out + ((size_t)e * 1024 + n0) * 1024 + k0; }
    else { const int jj = j - 64, e = 16 + (jj >> 2), up = (jj >> 1) & 1; src = (up ? F.in[31] : F.in[29]) + (size_t)e * D * D + (size_t)k0 * D + n0;
        dst = (bf16_t*)(F.ws + WS_W1T) + ((size_t)e * 2048 + (n0 >> 7) * 256 + up * 128 + (n0 & 127)) * 1024 + k0; }
}
__device__ __forceinline__ void cs_load(const Frame& F, int j, int ktb, int nt, int l8, int q, f4 (&cv)[8]) {
    const float* src; bf16_t* dst; cs_tile(F, j, ktb, nt, src, dst); src += (size_t)(l8 * 8) * D + q * 4;
#pragma unroll
    for (int i = 0; i < 8; ++i) asm volatile("global_load_dwordx4 %0, %1, off nt" : "=&v"(cv[i]) : "v"(src + (size_t)i * D) : "memory");
}
template <bool LAST = false> __device__ __forceinline__ void cs_store(const Frame& F, int j, int ktb, int nt, int l8, int q, f4 (&cv)[8]) {
    const float* src; bf16_t* dst; cs_tile(F, j, ktb, nt, src, dst); dst += (size_t)(q * 4) * 1024 + l8 * 8;
    if constexpr (LAST) asm volatile("s_waitcnt vmcnt(0)" ::: "memory");
    asm volatile("s_waitcnt vmcnt(8)" : "+v"(cv[0]), "+v"(cv[1]), "+v"(cv[2]), "+v"(cv[3]), "+v"(cv[4]), "+v"(cv[5]), "+v"(cv[6]), "+v"(cv[7]) :: "memory");
    u32x4 o;
    o.x = cvt_pk_bf16(cv[0].x, cv[1].x); o.y = cvt_pk_bf16(cv[2].x, cv[3].x); o.z = cvt_pk_bf16(cv[4].x, cv[5].x); o.w = cvt_pk_bf16(cv[6].x, cv[7].x); *(u32x4*)(dst) = o;
    o.x = cvt_pk_bf16(cv[0].y, cv[1].y); o.y = cvt_pk_bf16(cv[2].y, cv[3].y); o.z = cvt_pk_bf16(cv[4].y, cv[5].y); o.w = cvt_pk_bf16(cv[6].y, cv[7].y); *(u32x4*)(dst + 1024) = o;
    o.x = cvt_pk_bf16(cv[0].z, cv[1].z); o.y = cvt_pk_bf16(cv[2].z, cv[3].z); o.z = cvt_pk_bf16(cv[4].z, cv[5].z); o.w = cvt_pk_bf16(cv[6].z, cv[7].z); *(u32x4*)(dst + 2048) = o;
    o.x = cvt_pk_bf16(cv[0].w, cv[1].w); o.y = cvt_pk_bf16(cv[2].w, cv[3].w); o.z = cvt_pk_bf16(cv[4].w, cv[5].w); o.w = cvt_pk_bf16(cv[6].w, cv[7].w); *(u32x4*)(dst + 3072) = o;
}
__device__ __forceinline__ void p_chunk_scan(const Frame& F, const bf16_t* V, bf16_t* Y) {
    const int n = F.lane & 15, g = F.lane >> 4;
    const f32x4_t Z4 = {0.f, 0.f, 0.f, 0.f};
    constexpr int CKS_VS = 2, CKS_WG = 4 / CKS_VS;
    for (int u = F.bid; u < NB * NH * 2 * CKS_WG; u += F.G) {
        int chain, vpart;
        if (F.G == 256) { vpart = (u >> 3) % CKS_WG; chain = (u & 7) | ((u / (8 * CKS_WG)) << 3); } else { vpart = u % CKS_WG; chain = u / CKS_WG; }
        const int dir = chain & 1, h = (chain >> 1) & 7, b = chain >> 4;
        const unsigned char* fbase = F.ws + WS_FRAG + (size_t)chain * CK_NCH * CK_BYTES;
        __syncthreads();
        if (F.wave >= 4) {
            const int w = F.wave - 4;
#define CKR_DMA(c_) do { const unsigned char* p_ = fbase + (size_t)(c_) * CK_BYTES + F.lane * 16; LAS unsigned char* l_ = F.lds + ((c_) & (CKR_SLOTS - 1)) * CKR_SLOT; \
                _Pragma("unroll") for (int i_ = 0; i_ < 3; ++i_) { const int pc_ = i_ * 4 + w; \
                    if (pc_ < 10) __builtin_amdgcn_global_load_lds((const unsigned*)(p_ + pc_ * 1024), (LAS unsigned*)(l_ + pc_ * 1024), 16, 0, 0); \
                    else __builtin_amdgcn_global_load_lds((const unsigned*)(V + (size_t)ck_row(b, dir, (c_) * CK_C + (F.lane >> 3) + 8 * (pc_ - 10)) * RW + h * 64 + (F.lane & 7) * 8), (LAS unsigned*)(l_ + CKR_VOFF + (pc_ - 10) * 1024), 16, 0, 0); } } while (0)
#pragma unroll
            for (int c0 = 0; c0 < CKR_AHEAD; ++c0) CKR_DMA(c0);
            for (int c = 0; c < CK_NCH; ++c) {
                if (c + CKR_AHEAD - 1 < CK_NCH) asm volatile("s_waitcnt vmcnt(18)" ::: "memory"); else asm volatile("s_waitcnt vmcnt(0)" ::: "memory");
                __builtin_amdgcn_s_barrier();
                __builtin_amdgcn_s_barrier();
                if (c + CKR_AHEAD < CK_NCH) CKR_DMA(c + CKR_AHEAD);
            }
#undef CKR_DMA
        } else if (F.wave >= CKS_VS) {
            const int gq = u * 2 + (F.wave - CKS_VS), ktb = gq >> 5, nt = gq & 31, l8 = F.lane >> 3, q = F.lane & 7;
            f4 c0[8], c1[8];
            static_assert(CS_TILES % 4 == 0 && CS_TILES >= 64 && CS_TILES <= 128 && CK_NCH > CS_TILES * 2 + 2, "spare-wave schedule");
#define CS_BB __builtin_amdgcn_s_barrier(); __builtin_amdgcn_s_barrier();
            static_assert(CS_TILES == 64 && CK_NCH >= 8 * 32 + 4 + 8, "spare-wave schedule");
            CS_BB cs_load(F, 0, ktb, nt, l8, q, c0); CS_BB CS_BB CS_BB
            CS_BB cs_load(F, 1, ktb, nt, l8, q, c1); CS_BB CS_BB
            CS_BB cs_store(F, 0, ktb, nt, l8, q, c0);
            for (int m = 1; m < CS_TILES / 2; ++m) {
                CS_BB cs_load(F, 2 * m, ktb, nt, l8, q, c0); CS_BB CS_BB
                CS_BB cs_store(F, 2 * m - 1, ktb, nt, l8, q, c1);
                CS_BB cs_load(F, 2 * m + 1, ktb, nt, l8, q, c1); CS_BB CS_BB
                CS_BB cs_store(F, 2 * m, ktb, nt, l8, q, c0);
            }
            CS_BB CS_BB CS_BB
            CS_BB cs_store<true>(F, CS_TILES - 1, ktb, nt, l8, q, c1);
            for (int c = (CS_TILES / 2) * 8 + 4; c < CK_NCH; ++c) { CS_BB }
#undef CS_BB
        } else {
            const int vs = vpart * CKS_VS + (F.wave % CKS_VS); const bool act = true;
            bf16_t* Yd = Y + (size_t)dir * NTOK * RW;
            const size_t vcol = (size_t)h * 64 + vs * 16 + n;
            f32x4_t ST[4] = {Z4, Z4, Z4, Z4};
            __builtin_amdgcn_s_setprio(3);
            for (int c = 0; c < CK_NCH; ++c) {
                const bf16x8_t bS0 = pk8(ST[0], ST[1]), bS1 = pk8(ST[2], ST[3]);
                __builtin_amdgcn_s_barrier();
                LAS unsigned char* sl = F.lds + (c & (CKR_SLOTS - 1)) * CKR_SLOT;
                bf16x8_t f16[4]; bf16x4_t f8[10]; f32x4_t gm[4]; unsigned vq[4];
                if (act) {
#pragma unroll
                for (int i = 0; i < 4; ++i) f16[i] = *(LAS bf16x8_t*)(sl + i * 1024 + F.lane * 16);
#pragma unroll
                for (int i = 0; i < 10; ++i) f8[i] = *(LAS bf16x4_t*)(sl + 4096 + i * 512 + F.lane * 8);
#pragma unroll
                for (int i = 0; i < 4; ++i) gm[i] = *(LAS f32x4_t*)(sl + 9216 + g * 64 + i * 16);
#pragma unroll
                for (int j = 0; j < 4; ++j) vq[j] = *(LAS bf16_t*)(sl + CKR_VOFF + (4 * g + j) * 128 + (vs * 16 + n) * 2);
                }
                asm volatile("s_waitcnt lgkmcnt(0)" ::: "memory");
                __builtin_amdgcn_s_barrier();
                if (act) {
                u32x2 vw; vw.x = vq[0] | (vq[1] << 16); vw.y = vq[2] | (vq[3] << 16); const bf16x4_t VF = __builtin_bit_cast(bf16x4_t, vw);
                f32x4_t tu = MF32(f16[3], bS1, MF32(f16[2], bS0, Z4)), ty = MF32(f16[1], bS1, MF32(f16[0], bS0, Z4));
                asm volatile("s_nop 7" : "+v"(tu), "+v"(ty));
                f32x4_t U = MF16(f8[1], VF, tu), Yc = MF16(f8[0], VF, ty);
#pragma unroll
                for (int tp = 0; tp < 4; ++tp) ST[tp] = MF16(f8[6 + tp], VF, ST[tp] * gm[tp]);
                asm volatile("s_nop 7" : "+v"(U), "+v"(Yc));
                const bf16x4_t Up = pk4(U);
#pragma unroll
                for (int tp = 0; tp < 4; ++tp) ST[tp] = MF16(f8[2 + tp], Up, ST[tp]);
                asm volatile("s_nop 7" : "+v"(ST[0]), "+v"(ST[1]), "+v"(ST[2]), "+v"(ST[3]));
                if (c >= CTXL / CK_C) {
#pragma unroll
                    for (int i = 0; i < 4; ++i) Yd[(size_t)ck_row(b, dir, c * CK_C + 4 * g + i) * RW + vcol] = f2bf(Yc[i]);
                }
                }
            }
            __builtin_amdgcn_s_setprio(0);
        }
    }
}
__device__ __forceinline__ void p_readout(const Frame& F, const bf16_t* R, const bf16_t* KD, const bf16_t* V, const bf16_t* G, const bf16_t* Y, bf16_t* Ar, bool xlocal) {
    const float* r_k = F.in[16]; const float* gn_w = F.in[17]; const float* gn_b = F.in[18];
    const int c0 = F.lane * 8;
    const f4 rk0 = *(const f4*)(r_k + c0), rk1 = *(const f4*)(r_k + c0 + 4), gw0 = *(const f4*)(gn_w + c0), gw1 = *(const f4*)(gn_w + c0 + 4), gb0 = *(const f4*)(gn_b + c0), gb1 = *(const f4*)(gn_b + c0 + 4);
    const float rk[8] = {rk0.x, rk0.y, rk0.z, rk0.w, rk1.x, rk1.y, rk1.z, rk1.w}, gw[8] = {gw0.x, gw0.y, gw0.z, gw0.w, gw1.x, gw1.y, gw1.z, gw1.w}, gb[8] = {gb0.x, gb0.y, gb0.z, gb0.w, gb1.x, gb1.y, gb1.z, gb1.w};
    for (int it = 0; it < (xlocal ? 8 : (NTOK + F.G * 8 - 1) / (F.G * 8)); ++it) {
        const int row = xlocal ? (F.bid & 7) * 2048 + (F.bid >> 3) * 64 + F.wave * 8 + it : F.bid * 8 + F.wave + it * F.G * 8;
        if (row >= NTOK) break;
        const size_t o = (size_t)row * RW + c0;
        float y0[8], y1[8], r[8], k0[8], k1[8], v[8], g[8];
        unpack8(*(const u32x4*)(Y + o), y0); unpack8(*(const u32x4*)(Y + (size_t)NTOK * RW + o), y1); unpack8(*(const u32x4*)(R + o), r);
        unpack8(*(const u32x4*)(KD + o), k0); unpack8(*(const u32x4*)(KD + (size_t)NROW * RW + o), k1); unpack8(*(const u32x4*)(V + o), v); unpack8(*(const u32x4*)(G + o), g);
        float sy = 0.f, sb = 0.f;
#pragma unroll
        for (int j = 0; j < 8; ++j) { y0[j] += y1[j]; sy += y0[j]; sb = fmaf(r[j] * (k0[j] + k1[j]), rk[j], sb); }
        const float mu = sum8(sy) * (1.0f / 64.0f), bon = sum8(sb);
        float sq = 0.f;
#pragma unroll
        for (int j = 0; j < 8; ++j) { y0[j] -= mu; sq = fmaf(y0[j], y0[j], sq); }
        const float rs = rsqrtf(sum8(sq) * (1.0f / 64.0f) + 64e-5f);
        float oo[8];
#pragma unroll
        for (int j = 0; j < 8; ++j) oo[j] = (y0[j] * rs * gw[j] + gb[j] + bon * v[j]) * g[j];
        *(u32x4*)(Ar + o) = PK8(oo);
    }
}
__device__ __forceinline__ void moe_table(const Frame& F, LAS int* tb) {
    const unsigned* cnt = (const unsigned*)(F.ws + WS_CTL) + CW_CNT;
    __syncthreads();
    if (F.tid == 0) {
        int ts = 0;
        for (int e = 0; e < NE; ++e) { const int c = (int)cnt[e]; tb[e] = c; tb[32 + e] = ts; ts += (c + 255) / 256; }
        tb[64] = ts; tb[65] = ts;
    }
    __syncthreads();
}
struct FinRow { u32x2 y[4][4]; u32x2 x[4]; };
__device__ __forceinline__ void fin_load(const bf16_t* x1, const bf16_t* ys, int row, const int (&ps)[4], int lane, FinRow& fr) {
#pragma unroll
    for (int i = 0; i < 4; ++i) { const int cidx = i * 256 + lane * 4;
#pragma unroll
        for (int k = 0; k < 4; ++k) fr.y[i][k] = *(const u32x2*)(ys + (size_t)ps[k] * D + cidx);
        fr.x[i] = *(const u32x2*)(x1 + (size_t)row * D + cidx); }
}
__device__ __forceinline__ void fin_row(const Frame& F, int row, int lane, const FinRow& cur, const float (&wk)[4], const f4 (&gg4)[4], const f4 (&ga4)[4]) {
    f4 v[4]; float ss = 0.f;
#pragma unroll
    for (int i = 0; i < 4; ++i) { const int cidx = i * 256 + lane * 4;
        f4 s = (f4){0.f, 0.f, 0.f, 0.f};
#pragma unroll
        for (int k = 0; k < 4; ++k) { const u32x2 y = cur.y[i][k]; s.x = fmaf(wk[k], bf_lo(y.x), s.x); s.y = fmaf(wk[k], bf_hi(y.x), s.y); s.z = fmaf(wk[k], bf_lo(y.y), s.z); s.w = fmaf(wk[k], bf_hi(y.y), s.w); }
        { const u32x2 xw = cur.x[i]; v[i] = (f4){bf_lo(xw.x), bf_hi(xw.x), bf_lo(xw.y), bf_hi(xw.y)} + ga4[i] * s; }
        ss += v[i].x * v[i].x + v[i].y * v[i].y + v[i].z * v[i].z + v[i].w * v[i].w; }
    ss = wave_sum(ss);
    const float rs = rsqrtf(ss * (1.0f / D) + 1e-6f);
#pragma unroll
    for (int i = 0; i < 4; ++i) { const int cidx = i * 256 + lane * 4; const f4 gg = gg4[i];
        f4 o; o.x = v[i].x * rs * gg.x; o.y = v[i].y * rs * gg.y; o.z = v[i].z * rs * gg.z; o.w = v[i].w * rs * gg.w;
        *(f4*)(F.out + (size_t)row * D + cidx) = o; }
}
__device__ __forceinline__ void p_final(const Frame& F, const bf16_t* x1, const bf16_t* ys) {
    const float* g = F.in[35]; const float* mod = (const float*)(F.ws + WS_MOD);
    const int lane = __builtin_amdgcn_mbcnt_hi(~0u, __builtin_amdgcn_mbcnt_lo(~0u, 0u));
    const int* pos = (const int*)(F.ws + WS_POS); const float* wgt = (const float*)(F.ws + WS_WGT);
    const int step = F.G * 8;
    int row = F.bid * 8 + F.wave;
    if (row >= NTOK) return;
    f4 gg4[4];
#pragma unroll
    for (int i = 0; i < 4; ++i) gg4[i] = *(const f4*)(g + i * 256 + lane * 4);
    int ps[4], nps[4]; float wk[4], nwk[4];
#pragma unroll
    for (int k = 0; k < 4; ++k) { ps[k] = pos[row * 4 + k]; wk[k] = wgt[row * 4 + k]; }
    FinRow A, B;
    fin_load(x1, ys, row, ps, lane, A);
    { const int nrow = row + step < NTOK ? row + step : row;
#pragma unroll
      for (int k = 0; k < 4; ++k) { nps[k] = pos[nrow * 4 + k]; nwk[k] = wgt[nrow * 4 + k]; } }
#define FIN_STEP(CUR, NXT) { const int nrow = row + step < NTOK ? row + step : row, nnrow = nrow + step < NTOK ? nrow + step : nrow; \
        f4 ga4[4];       \
        _Pragma("unroll") for (int i = 0; i < 4; ++i) ga4[i] = *(const f4*)(mod + (row / SEQ) * 6144 + 5120 + i * 256 + lane * 4); \
        fin_load(x1, ys, nrow, nps, lane, NXT); \
        int qs[4]; float qw[4]; \
        _Pragma("unroll") for (int k = 0; k < 4; ++k) { qs[k] = pos[nnrow * 4 + k]; qw[k] = wgt[nnrow * 4 + k]; } \
        fin_row(F, row, lane, CUR, wk, gg4, ga4); \
        _Pragma("unroll") for (int k = 0; k < 4; ++k) { wk[k] = nwk[k]; nps[k] = qs[k]; nwk[k] = qw[k]; } \
        row += step; }
    for (;;) {
        FIN_STEP(A, B) if (row >= NTOK) break;
        FIN_STEP(B, A) if (row >= NTOK) break;
    }
#undef FIN_STEP
}

typedef float f32x16 __attribute__((ext_vector_type(16)));
__device__ __forceinline__ int crow32(int reg, int h) { return (reg & 3) + 8 * (reg >> 2) + 4 * h; }
__device__ __forceinline__ void split_hi_lo(const float (&u)[8], bf16x8_t& hi, bf16x8_t& lo) {
    u32x4 ph, pl;
#pragma unroll
    for (int j = 0; j < 4; ++j) { const unsigned w = cvt_pk_bf16(u[2 * j], u[2 * j + 1]); ph[j] = w;
        pl[j] = cvt_pk_bf16(u[2 * j] - bf_lo(w), u[2 * j + 1] - bf_hi(w)); }
    hi = __builtin_bit_cast(bf16x8_t, ph); lo = __builtin_bit_cast(bf16x8_t, pl);
}
__device__ __forceinline__ void p_cvt_router(const Frame& F) {
    const float* rw = F.in[27]; bf16_t* hi = (bf16_t*)(F.ws + WS_WRT); bf16_t* lo = hi + 32 * 1024;
    for (int idx = F.bid * NT + F.tid; idx < 32 * 1024; idx += F.G * NT) { const int e = idx >> 10, k = idx & 1023; const float v = rw[k * NE + e];
        const unsigned w = cvt_pk_bf16(v, 0.f); hi[idx] = (bf16_t)(w & 0xffffu); lo[idx] = f2bf(v - bf_lo(w)); }
}
__device__ __forceinline__ void p_router_consts(const Frame& F) {
    const float* mod = (const float*)(F.ws + WS_MOD); const float* g = F.in[26];
    float* gs2 = (float*)(F.ws + WS_GS2);
    if (F.bid == F.G - 1) { for (int i = F.tid; i < 4 * 1024; i += NT) { const int b = i >> 10, k = i & 1023; gs2[i] = g[k] * (1.0f + mod[b * 6144 + 4096 + k]); } }
}
__device__ __forceinline__ void p_router2(const Frame& F, const bf16_t* x1, bf16_t* h2) {
    const float* mod = (const float*)(F.ws + WS_MOD); const float* ssp = (const float*)(F.ws + WS_SSP); const float* rb = F.in[28];
    const bf16_t* whi = (const bf16_t*)(F.ws + WS_WRT); const bf16_t* wlo = whi + 32 * 1024;
    const float* gs2 = (const float*)(F.ws + WS_GS2);
    unsigned* cnt = (unsigned*)(F.ws + WS_CTL) + CW_CNT; int* lst = (int*)(F.ws + WS_LIST); float* wgt = (float*)(F.ws + WS_WGT);
    const int tl = F.wave >> 2, kp = F.wave & 3, r = F.lane & 31, h = F.lane >> 5;
    LAS float* part = F.sm + (tl * 4 + kp) * 1024;
    LAS float* lg = F.sm + 8192 + 1024 + tl * (32 * 33);
    for (int t0 = F.bid * 2; t0 < NTOK / 32; t0 += F.G * 2) {
        const int row0 = (t0 + tl) * 32, b = row0 / SEQ;
        const bf16_t* xr = x1 + (size_t)(row0 + r) * D + kp * 256 + 8 * h;
        bf16_t* hr = h2 + (size_t)(row0 + r) * D + kp * 256 + 8 * h;
        const float* gp = gs2 + b * 1024 + kp * 256 + 8 * h; const float* sp = mod + b * 6144 + 3072 + kp * 256 + 8 * h;
        const bf16_t* wh = whi + r * 1024 + kp * 256 + 8 * h; const bf16_t* wl = wlo + r * 1024 + kp * 256 + 8 * h;
        float rstd;
        { const f4* q = (const f4*)(ssp + (size_t)(row0 + r) * 16); const f4 q0 = q[0], q1 = q[1], q2 = q[2], q3 = q[3];
          const float tot = (((q0.x + q0.y) + (q0.z + q0.w)) + ((q1.x + q1.y) + (q1.z + q1.w))) + (((q2.x + q2.y) + (q2.z + q2.w)) + ((q3.x + q3.y) + (q3.z + q3.w)));
          rstd = rsqrtf(tot * (1.0f / D) + 1e-6f); }
        f32x16 acc;
#pragma unroll
        for (int i = 0; i < 16; ++i) acc[i] = 0.f;
#pragma unroll 4
        for (int ks = 0; ks < 16; ++ks) {
            const u32x4 xw = *(const u32x4*)(xr + ks * 16); const f4 g0 = *(const f4*)(gp + ks * 16), g1 = *(const f4*)(gp + ks * 16 + 4);
            const f4 s0 = *(const f4*)(sp + ks * 16), s1 = *(const f4*)(sp + ks * 16 + 4);
            const bf16x8_t bh = *(const bf16x8_t*)(wh + ks * 16), bl = *(const bf16x8_t*)(wl + ks * 16);
            const float u[8] = {bf_lo(xw.x) * rstd * g0.x + s0.x, bf_hi(xw.x) * rstd * g0.y + s0.y, bf_lo(xw.y) * rstd * g0.z + s0.z, bf_hi(xw.y) * rstd * g0.w + s0.w,
                                bf_lo(xw.z) * rstd * g1.x + s1.x, bf_hi(xw.z) * rstd * g1.y + s1.y, bf_lo(xw.w) * rstd * g1.z + s1.z, bf_hi(xw.w) * rstd * g1.w + s1.w};
            bf16x8_t ah, al; split_hi_lo(u, ah, al);
            *(bf16x8_t*)(hr + ks * 16) = ah;
            acc = __builtin_amdgcn_mfma_f32_32x32x16_bf16(ah, bh, acc, 0, 0, 0);
            acc = __builtin_amdgcn_mfma_f32_32x32x16_bf16(al, bh, acc, 0, 0, 0);
            acc = __builtin_amdgcn_mfma_f32_32x32x16_bf16(ah, bl, acc, 0, 0, 0);
        }
        asm volatile("s_nop 15\n\ts_nop 7" : "+v"(acc));
        __syncthreads();
#pragma unroll
        for (int i = 0; i < 16; ++i) part[i * 64 + F.lane] = acc[i];
        __syncthreads();
        if (kp == 0) {
            LAS float* p0 = F.sm + (tl * 4) * 1024;
            const float bb = rb[r];
#pragma unroll
            for (int i = 0; i < 16; ++i) { const float a = (p0[i * 64 + F.lane] + p0[1024 + i * 64 + F.lane]) + (p0[2048 + i * 64 + F.lane] + p0[3072 + i * 64 + F.lane]);
                const int rw_ = crow32(i, h); lg[rw_ * 33 + r] = a + bb; }
            __builtin_amdgcn_wave_barrier(); asm volatile("s_waitcnt lgkmcnt(0)" ::: "memory");
            if (F.lane < 32) {
                float tv[4]; int te[4]; unsigned used = 0u;
#pragma unroll
                for (int k = 0; k < 4; ++k) { float best = -3.0e38f; int bi = 0;
#pragma unroll
                    for (int e = 0; e < 32; ++e) { const float x = lg[F.lane * 33 + e]; if (!((used >> e) & 1u) && x > best) { best = x; bi = e; } }
                    used |= 1u << bi; tv[k] = best; te[k] = bi; }
                float ex[4], sum = 0.f;
#pragma unroll
                for (int k = 0; k < 4; ++k) { ex[k] = expf(tv[k] - tv[0]); sum += ex[k]; }
                const int row = row0 + F.lane;
#pragma unroll
                for (int k = 0; k < 4; ++k) { const unsigned pos = atomicAdd(&cnt[te[k]], 1u); lst[(size_t)te[k] * ECAP + pos] = row * 4 + k; wgt[row * 4 + k] = ex[k] / sum; }
            }
        }
    }
}
constexpr int SG_PITCH = 272;
__device__ __forceinline__ void p_sgu2(const Frame& F, const bf16_t* Gs, bf16_t* As_, int u0, int ustride) {
    const float* lnw = F.in[20]; const float* lnb = F.in[21]; const float* Wsp = F.in[22]; const float* bsp = F.in[23];
    LAS unsigned char* zt = F.lds;
    const int r = F.lane & 31, h = F.lane >> 5;
    for (int u = u0; u < NB * 32 * 2; u += ustride) {
        const int gh = u & 1, n = (u >> 1) & 31, b = u >> 6;
        const int row0 = b * SEQ + n * 128;
        __syncthreads();
        u32x4 zws[16];
#pragma unroll
        for (int i = 0; i < 16; ++i) zws[i] = *(const u32x4*)(Gs + (size_t)(row0 + F.wave + 8 * i) * 1024 + 512 + F.lane * 8);
        float lw8[8], lb8[8];
        { const f4 a0 = *(const f4*)(lnw + F.lane * 8), a1 = *(const f4*)(lnw + F.lane * 8 + 4), b0 = *(const f4*)(lnb + F.lane * 8), b1 = *(const f4*)(lnb + F.lane * 8 + 4);
          lw8[0] = a0.x; lw8[1] = a0.y; lw8[2] = a0.z; lw8[3] = a0.w; lw8[4] = a1.x; lw8[5] = a1.y; lw8[6] = a1.z; lw8[7] = a1.w;
          lb8[0] = b0.x; lb8[1] = b0.y; lb8[2] = b0.z; lb8[3] = b0.w; lb8[4] = b1.x; lb8[5] = b1.y; lb8[6] = b1.z; lb8[7] = b1.w; }
#pragma unroll
        for (int i = 0; i < 16; ++i) { const int p = F.wave + 8 * i;
            const u32x4 zw = zws[i];
            float z[8] = {bf_lo(zw.x), bf_hi(zw.x), bf_lo(zw.y), bf_hi(zw.y), bf_lo(zw.z), bf_hi(zw.z), bf_lo(zw.w), bf_hi(zw.w)};
            float sm_ = 0.f;
#pragma unroll
            for (int j = 0; j < 8; ++j) sm_ += z[j];
            const float mu = wave_sum(sm_) * (1.0f / 512.0f);
            float q = 0.f;
#pragma unroll
            for (int j = 0; j < 8; ++j) { const float d = z[j] - mu; q += d * d; }
            const float rs = rsqrtf(wave_sum(q) * (1.0f / 512.0f) + 1e-5f);
            if ((F.lane >> 5) == gh) { const int cl = (F.lane & 31) * 8, ch = F.lane * 8;
#pragma unroll
                for (int j = 0; j < 8; ++j) *(LAS bf16_t*)(zt + (cl + j) * SG_PITCH + p * 2) = f2bf((z[j] - mu) * rs * lw8[j] + lb8[j]); }
        }
        __syncthreads();
        const int ct = F.wave & 1, pt = F.wave >> 1;
#pragma unroll 1
        for (int gl = 0; gl < 4; ++gl) {
            const int g = gh * 4 + gl;
            f32x16 acc;
#pragma unroll
            for (int i = 0; i < 16; ++i) acc[i] = 0.f;
            const float* wp = Wsp + ((size_t)g * 128 + pt * 32 + r) * 128 + 8 * h;
            LAS unsigned char* ap = zt + (gl * 64 + ct * 32 + r) * SG_PITCH + 16 * h;
#pragma unroll
            for (int ks = 0; ks < 8; ++ks) {
                const bf16x8_t a = *(LAS bf16x8_t*)(ap + ks * 32);
                const f4 w0 = *(const f4*)(wp + ks * 16), w1 = *(const f4*)(wp + ks * 16 + 4);
                u32x4 bw; bw.x = cvt_pk_bf16(w0.x, w0.y); bw.y = cvt_pk_bf16(w0.z, w0.w); bw.z = cvt_pk_bf16(w1.x, w1.y); bw.w = cvt_pk_bf16(w1.z, w1.w);
                acc = __builtin_amdgcn_mfma_f32_32x32x16_bf16(a, __builtin_bit_cast(bf16x8_t, bw), acc, 0, 0, 0);
            }
            asm volatile("s_nop 15\n\ts_nop 7" : "+v"(acc));
            const int p = pt * 32 + r, row = row0 + p; const float bias = bsp[g * 128 + p];
#pragma unroll
            for (int q4 = 0; q4 < 4; ++q4) { const int c = ct * 32 + 8 * q4 + 4 * h;
                const u32x2 uw = *(const u32x2*)(Gs + (size_t)row * 1024 + g * 64 + c);
                u32x2 o; o.x = cvt_pk_bf16(bf_lo(uw.x) * (acc[q4 * 4 + 0] + bias), bf_hi(uw.x) * (acc[q4 * 4 + 1] + bias));
                o.y = cvt_pk_bf16(bf_lo(uw.y) * (acc[q4 * 4 + 2] + bias), bf_hi(uw.y) * (acc[q4 * 4 + 3] + bias));
                *(u32x2*)(As_ + (size_t)row * RW + g * 64 + c) = o; }
        }
    }
}

constexpr int LDS_BYTES = mg::STAGE_BYTES + 16384;
constexpr int N_PHASES = 16;

__global__ void __launch_bounds__(NT, 2) fwd_kernel(Args args) {
    extern __shared__ __attribute__((aligned(16))) unsigned char lds_raw[];
    Frame F;
    F.in = args.in; F.out = args.out; F.ws = args.ws;
    F.sm = (LAS float*)lds_raw; F.lds = (LAS unsigned char*)lds_raw;
    F.tid = threadIdx.x; F.lane = F.tid & 63; F.wave = __builtin_amdgcn_readfirstlane(F.tid >> 6); F.G = gridDim.x; F.bid = blockIdx.x;
    volatile LAS unsigned* xbw = (volatile LAS unsigned*)(lds_raw + LDS_BYTES - 16);
    LAS int* tb = (LAS int*)(lds_raw + mg::STAGE_BYTES);
    if (F.tid == 0) { xbw[0] = 0u; xbw[1] = 0u; xbw[2] = 0u; xbw[3] = 0u; }
    __syncthreads();
    unsigned xrank;
    XcdBarrier bar = xcd_barrier_post((unsigned*)(F.ws + WS_CTL), xbw, xrank);
    if (F.tid == 0) { unsigned nloc, nx; unsigned* bw = (unsigned*)(F.ws + WS_CTL);
        xcd_barrier_complete(bw, bar.x, nloc, nx); xbw[0] = nloc; xbw[1] = nx;
        bool uni = (F.G % 8 == 0) && nx == 8u && bar.x < 8u;
        for (unsigned j = 0; j < 8u; ++j) uni = uni && (xb_ld(&bw[XB_XCNT(j)]) == (unsigned)F.G / 8u);
        xbw[2] = uni ? xrank * 8u + bar.x : (unsigned)blockIdx.x; xbw[3] = uni ? 1u : 0u; }
    __syncthreads();
    F.bid = __builtin_amdgcn_readfirstlane((int)xbw[2]); const bool xlocal = __builtin_amdgcn_readfirstlane((int)xbw[3]) != 0 && F.G == 256;
    const int lo = args.ph_lo, hi = args.ph_hi;
#ifndef PH_MASK
#define PH_MASK 0xFFFFFFFFu
#endif
#define IN(k) (((PH_MASK >> (k)) & 1u) && lo <= (k) && (k) < hi)
#define SEAM(k) do { if (IN(k) && IN((k) + 1)) xcd_barrier(bar); } while (0)
#define SEAM_LOCAL(k) do { if (IN(k) && IN((k) + 1)) { if (xlocal) xcd_local_barrier(bar); else xcd_barrier(bar); } } while (0)
    unsigned char* ws = F.ws;
    float* mod = (float*)(ws + WS_MOD);
    bf16_t* Hb = (bf16_t*)(ws + WS_H); bf16_t* Prw = (bf16_t*)(ws + WS_PRW); bf16_t* GateA = (bf16_t*)(ws + WS_GA); bf16_t* Gsgu = (bf16_t*)(ws + WS_GSGU); bf16_t* GateB = (bf16_t*)(ws + WS_GB);
    bf16_t* Asg = (bf16_t*)(ws + WS_AS); bf16_t* Mb = (bf16_t*)(ws + WS_M);
    bf16_t* Rr = (bf16_t*)(ws + WS_R); bf16_t* LW = (bf16_t*)(ws + WS_LW); bf16_t* Kraw = (bf16_t*)(ws + WS_KRAW); bf16_t* Alora = (bf16_t*)(ws + WS_ALORA);
    bf16_t* Aa = (bf16_t*)(ws + WS_A); bf16_t* Vv = (bf16_t*)(ws + WS_V); bf16_t* KD = (bf16_t*)(ws + WS_KD); bf16_t* Bd = (bf16_t*)(ws + WS_B); bf16_t* Gg = (bf16_t*)(ws + WS_G);
    bf16_t* Yd = (bf16_t*)(ws + WS_YD); bf16_t* Arb = (bf16_t*)(ws + WS_AR);
    bf16_t* X1 = (bf16_t*)(ws + WS_X1); bf16_t* H2 = (bf16_t*)(ws + WS_H2); bf16_t* Act = (bf16_t*)(ws + WS_ACT);
    bf16_t* W1t = (bf16_t*)(ws + WS_W1T); bf16_t* W2t = (bf16_t*)F.out; bf16_t* Ys = (bf16_t*)(ws + 292 * MiB);
    const int* lst = (const int*)(ws + WS_LIST); const float* wgt = (const float*)(ws + WS_WGT);

    if (IN(0)) { p_mod_cvt_small(F); if (F.G * NT < 32 * 1024) p_cvt_router(F); p_cvt_lora(F); }
    SEAM(0);
    if (IN(1)) { p_router_consts(F);
        if (F.G == 256) { unsigned* ctr = (unsigned*)(ws + WS_CTL) + CW_CTX;
            if (F.bid < 128) { p_norm1(F, Hb, NTOK, NROW, F.bid, 128); ctr_signal(ctr); }
            if (F.bid >= 224) { ctr_wait(ctr, 128u, (unsigned*)(ws + WS_CTL)); mg::PProb P{Hb, (const bf16_t*)(ws + WS_WINT), 32, F.bid - 224, 1024, 1056}; mg::EpiP E{Prw, Gsgu, GateA}; mg::gemm_run(F.lds, P, E); }
            else if (xlocal) p_norm1(F, Hb, (F.bid & 7) * 2048, (F.bid & 7) * 2048 + 2048, F.bid >> 3, 28);
            else p_norm1(F, Hb, 0, NTOK, F.bid, 224);
        } else p_norm1(F, Hb, 0, NROW, F.bid, F.G); }
    SEAM_LOCAL(1);
    if (IN(2)) { mg::PProb P{Hb, (const bf16_t*)(ws + WS_WINT), F.G, F.bid, 0, F.G == 256 ? 1024 : 1056}; mg::EpiP E{Prw, Gsgu, GateA}; mg::gemm_run(F.lds, P, E); }
    SEAM(2);
    if (IN(5)) p_prepA(F, Prw, Rr, Kraw, Vv, Aa, Alora);
    SEAM(5);
    if (IN(6)) { mg::LoraProb P{Alora, (const bf16_t*)(ws + WS_LORAT), F.G, F.bid}; mg::EpiLora E{LW, KD, Bd, Gg, Kraw, Aa, F.in[9], F.in[11], F.in[15]}; mg::gemm_run(F.lds, P, E); }
    SEAM(6);
#ifdef USE_SEQ_SCAN
    if (IN(7)) p_scan<0>(F, Rr, Aa, Vv, LW, KD, Bd, Yd);
#else
    if (IN(7)) { p_chunk_pre(F, Rr, Aa, LW, KD, Bd); xcd_barrier(bar);
        if (F.G >= 256) { if (F.bid < 128) p_chunk_scan(F, Vv, Yd);
            else { p_sgu2(F, Gsgu, Asg, F.bid - 128, F.G - 128);
                   mg::DenseProb P{Hb, (const bf16_t*)(ws + WS_WINT) + (size_t)4096 * 1024, 64, 4, 1024, F.G - 128, F.bid - 128}; mg::EpiSig E{GateB}; mg::gemm_run(F.lds, P, E);
                   __syncthreads(); p_cvt_experts(F, 16 + (CS_TILES - 64) / 4, 32, F.bid - 128, F.G - 128); } }
        else { p_chunk_scan(F, Vv, Yd); p_sgu2(F, Gsgu, Asg, F.bid, F.G);
               mg::DenseProb P{Hb, (const bf16_t*)(ws + WS_WINT) + (size_t)4096 * 1024, 64, 4, 1024, F.G, F.bid}; mg::EpiSig E{GateB}; mg::gemm_run(F.lds, P, E);
               __syncthreads(); p_cvt_experts(F, 16 + (CS_TILES - 64) / 4, 32, F.bid, F.G); } }
#endif
    SEAM(7);
    if (IN(8)) p_readout(F, Rr, KD, Vv, Gg, Yd, Arb, xlocal);
    SEAM_LOCAL(8);
    if (IN(9)) { if (F.G == 256) { mg::YYProb P{Asg, Arb, (const bf16_t*)(ws + WS_WOS), (const bf16_t*)(ws + WS_WOR), F.G, F.bid}; mg::EpiYY E{Mb, GateA, GateB}; mg::gemm_run(F.lds, P, E); }
        else {
        { mg::DenseProb P{Asg, (const bf16_t*)(ws + WS_WOS), 64, 4, 512, F.G, F.bid}; mg::EpiGateMul<false> E{Mb, GateB}; mg::gemm_run(F.lds, P, E); }
        { mg::DenseProb P{Arb, (const bf16_t*)(ws + WS_WOR), 64, 4, 512, F.G, F.bid}; mg::EpiGateMul<true> E{Mb, GateA}; mg::gemm_run(F.lds, P, E); } } }
    SEAM_LOCAL(9);
    if (IN(10)) { mg::DenseProb P{Mb, (const bf16_t*)(ws + WS_WOT), 64, 4, 1024, F.G, F.bid}; mg::EpiX1 E{X1, F.in[0], mod, (float*)(ws + WS_SSP)}; mg::gemm_run(F.lds, P, E); }
    SEAM(10);
#ifdef USE_SEQ_SCAN
    if (IN(11)) { p_router2(F, X1, H2); if (F.G != 256) p_cvt_experts(F, 0, 16, F.bid, F.G); }
#else
    if (IN(11)) { f4 cva[8]; cvt_ex_load(F, F.bid, cva);
                  p_router2(F, X1, H2); p_cvt_experts<true>(F, 0, 16, F.bid, F.G, cva); }
#endif
    SEAM(11);
    int moe_r1 = 0, moe_fill = 0, moe_rank = -1; bool moe_has_last = false;
    if (IN(12)) { moe_table(F, tb); LAS int* rtab = (LAS int*)(lds_raw + mg::STAGE_BYTES + 1024);
        const int RT = tb[65], S1 = (RT + 3) >> 2; moe_r1 = F.G == 256 ? (S1 + 7) >> 3 : 0;
        if (F.G == 256 && moe_r1 >= 2) {
            int nidle = 0, rank = -1;
            for (int cc = 0; cc < 256; ++cc) { const bool has = 4 * ((moe_r1 - 1) * 8 + (cc & 7)) + ((cc >> 3) & 3) < RT; if (cc == F.bid) { moe_has_last = has; rank = nidle; } if (!has) ++nidle; }
            moe_fill = nidle >> 5;
            if (moe_fill * 8 > (moe_r1 - 1) * 32) moe_fill = ((moe_r1 - 1) * 32) >> 3;
            if (moe_fill * 8 > RT) moe_fill = RT >> 3;
            moe_rank = (!moe_has_last && rank < moe_fill * 32) ? rank : -1;
            mg::Moe1Prob P{H2, W1t, lst, tb, rtab, F.G, F.bid, 0, moe_r1 - 1}; P.fill(rtab, (int*)(ws + WS_POS)); mg::EpiMoe1 E{Act, F.in[30], F.in[32]}; mg::gemm_run(F.lds, P, E);
        } else { moe_r1 = 0; mg::Moe1Prob P{H2, W1t, lst, tb, rtab, F.G, F.bid, 0, 1 << 20}; P.fill(rtab, (int*)(ws + WS_POS)); mg::EpiMoe1 E{Act, F.in[30], F.in[32]}; mg::gemm_run(F.lds, P, E); }
    }
    SEAM(12);
    if (IN(13)) { LAS int* rtab = (LAS int*)(lds_raw + mg::STAGE_BYTES + 1024);
        if (moe_r1 >= 2) {
            if (moe_has_last) { mg::Moe1Prob P{H2, W1t, lst, tb, rtab, F.G, F.bid, moe_r1 - 1, moe_r1}; P.fill(rtab, (int*)(ws + WS_POS)); mg::EpiMoe1 E{Act, F.in[30], F.in[32]}; mg::gemm_run(F.lds, P, E); }
            else if (moe_rank >= 0) { mg::Moe2Prob P{Act, W2t, tb, F.G, F.bid, 0, moe_rank}; mg::EpiMoe2 E{Ys, F.in[34]}; mg::gemm_run(F.lds, P, E); }
            xcd_barrier(bar);
        }
        { mg::Moe2Prob P{Act, W2t, tb, F.G, F.bid, moe_fill, -1}; mg::EpiMoe2 E{Ys, F.in[34]}; mg::gemm_run(F.lds, P, E); }
    }
    SEAM(13);
    if (IN(14)) p_final(F, X1, Ys);
#undef IN
#undef SEAM
}

extern "C" void kernel_launch(void* const* d_in, const int* in_sizes, int n_in, void* d_out, int out_size, void* d_ws, size_t ws_size, hipStream_t stream) {
    static int grid = 0;
    if (grid == 0) {
        if (n_in != 36 || out_size != NTOK * D || ws_size < WS_END) { fprintf(stderr, "kernel_launch: unexpected shapes (n_in %d out %d ws %zu, need %zu)\n", n_in, out_size, ws_size, (size_t)WS_END); grid = -1; return; }
        int dev = 0, cus = 0, per_cu = 0;
        if (hipGetDevice(&dev) != hipSuccess || hipDeviceGetAttribute(&cus, hipDeviceAttributeMultiprocessorCount, dev) != hipSuccess) { grid = -1; return; }
        if (hipFuncSetAttribute((const void*)fwd_kernel, hipFuncAttributeMaxDynamicSharedMemorySize, LDS_BYTES) != hipSuccess) { grid = -1; return; }
        if (hipOccupancyMaxActiveBlocksPerMultiprocessor(&per_cu, (const void*)fwd_kernel, NT, LDS_BYTES) != hipSuccess || per_cu < 1) { fprintf(stderr, "occupancy query: %d\n", per_cu); }
        (void)hipGetLastError();
        grid = cus;
    }
    if (grid < 0) return;
    (void)hipMemsetAsync((char*)d_ws + WS_CTL, 0, 20480, stream);
    Args a{};
    for (int i = 0; i < 36; ++i) a.in[i] = (const float*)d_in[i];
    a.out = (float*)d_out; a.ws = (unsigned char*)d_ws; a.ph_lo = 0; a.ph_hi = N_PHASES;
    hipLaunchKernelGGL(fwd_kernel, dim3(grid), dim3(NT), LDS_BYTES, stream, a);
}
```
